# Optimizing an MI355X kernel written in HIP

```python
import math
import jax, jax.numpy as jnp
from jax import lax
import numpy as np

D_MODEL = 4096
BATCH = 1
SEQ = 8192
DEPTH = 1
DEC_BATCH = 4
DEC_SEQ = 4096
PAST_LEN = 128

HEAD_DIM = 128
N_HEADS_TOTAL = D_MODEL // HEAD_DIM
HA = N_HEADS_TOTAL // 2
KVA = HA // 4
GA = HA // KVA
HB = N_HEADS_TOTAL // 2
KVB = HB // 4
GB = HB // KVB
QA_W = HA * HEAD_DIM
KVA_W = KVA * HEAD_DIM
QB_W = HB * HEAD_DIM
KVB_W = KVB * HEAD_DIM
IN_W = QA_W + 2 * KVA_W + QB_W + 2 * KVB_W + 2 * D_MODEL
SPLITS = [int(v) for v in np.cumsum([QA_W, KVA_W, KVA_W, QB_W, KVB_W, KVB_W, D_MODEL])]
D_FF = ((8 * D_MODEL // 3 + 255) // 256) * 256
GRID_W = 64
Q_BLOCK = 128
WINDOW = 128
HALF_ROT = HEAD_DIM // 2
ROPE_THETA = 10000.0
N_MOD = 6
ALPHA = (2.0 * DEPTH) ** 0.25
BETA = (8.0 * DEPTH) ** -0.25
LN_EPS = 1e-5
RMS_EPS = 1e-6

kernel_name = "hybrid_axial_window_gqa_encoder"


def layer_norm(x, g=None, b=None):
    xf = x.astype(jnp.float32)
    mu = jnp.mean(xf, axis=-1, keepdims=True)
    xc = xf - mu
    y = xc * lax.rsqrt(jnp.mean(xc * xc, axis=-1, keepdims=True) + LN_EPS)
    if g is not None:
        y = y * g.astype(jnp.float32) + b.astype(jnp.float32)
    return y.astype(x.dtype)


def rms_norm(x, g):
    xf = x.astype(jnp.float32)
    y = xf * lax.rsqrt(jnp.mean(xf * xf, axis=-1, keepdims=True) + RMS_EPS) * g.astype(jnp.float32)
    return y.astype(x.dtype)


def axial_rope_tables(T):
    rows = T // GRID_W
    row = jnp.repeat(jnp.arange(rows, dtype=jnp.float32), GRID_W)
    col = jnp.tile(jnp.arange(GRID_W, dtype=jnp.float32), rows)
    inv = 1.0 / (ROPE_THETA ** (jnp.arange(0, HALF_ROT, 2, dtype=jnp.float32) / HALF_ROT))
    ang_r = row[:, None] * inv[None, :]
    ang_c = col[:, None] * inv[None, :]
    return jnp.cos(ang_r), jnp.sin(ang_r), jnp.cos(ang_c), jnp.sin(ang_c)


def rotate(x, cos, sin):
    x1, x2 = jnp.split(x, 2, axis=-1)
    c = cos[None, :, None, :].astype(x.dtype)
    s = sin[None, :, None, :].astype(x.dtype)
    return jnp.concatenate([x1 * c - x2 * s, x2 * c + x1 * s], axis=-1)


def axial_rope(x, cr, sr, cc, sc):
    return jnp.concatenate([rotate(x[..., :HALF_ROT], cr, sr), rotate(x[..., HALF_ROT:], cc, sc)], axis=-1)


def alibi_slopes(n):
    return 2.0 ** (-8.0 * jnp.arange(1, n + 1, dtype=jnp.float32) / n)


def global_attention(q, k, v):
    B, T, KV, G, hd = q.shape
    nb = T // Q_BLOCK
    qb = (q * (1.0 / math.sqrt(hd))).reshape(B, nb, Q_BLOCK, KV, G, hd).transpose(1, 0, 2, 3, 4, 5)

    def block(qi):
        s = jnp.einsum('bqkgd,bskd->bkgqs', qi, k).astype(jnp.float32)
        p = jax.nn.softmax(s, axis=-1).astype(v.dtype)
        return jnp.einsum('bkgqs,bskd->bqkgd', p, v)

    o = lax.map(block, qb)
    return o.transpose(1, 0, 2, 3, 4, 5).reshape(B, T, KV * G * hd)


def window_attention(q, k, v, sink):
    B, T, KV, G, hd = q.shape
    nb = T // Q_BLOCK
    pad = ((0, 0), (Q_BLOCK, Q_BLOCK), (0, 0), (0, 0))
    kp = jnp.pad(k, pad).reshape(B, nb + 2, Q_BLOCK, KV, hd)
    vp = jnp.pad(v, pad).reshape(B, nb + 2, Q_BLOCK, KV, hd)
    kw = jnp.concatenate([kp[:, :-2], kp[:, 1:-1], kp[:, 2:]], axis=2)
    vw = jnp.concatenate([vp[:, :-2], vp[:, 1:-1], vp[:, 2:]], axis=2)
    qb = (q * (1.0 / math.sqrt(hd))).reshape(B, nb, Q_BLOCK, KV, G, hd)
    s = jnp.einsum('bnqkgd,bnskd->bnkgqs', qb, kw).astype(jnp.float32)
    qpos = jnp.arange(T).reshape(nb, Q_BLOCK)
    kpos = jnp.arange(nb)[:, None] * Q_BLOCK - Q_BLOCK + jnp.arange(3 * Q_BLOCK)[None, :]
    dist = jnp.abs(qpos[:, :, None] - kpos[:, None, :])
    valid = (dist <= WINDOW) & (kpos >= 0)[:, None, :] & (kpos < T)[:, None, :]
    slopes = alibi_slopes(KV * G).reshape(KV, G)
    bias = -slopes[None, None, :, :, None, None] * dist.astype(jnp.float32)[None, :, None, None, :, :]
    s = jnp.where(valid[None, :, None, None, :, :], s + bias, -1e30)
    sink_col = jnp.broadcast_to(sink.astype(jnp.float32)[None, None, :, :, None, None], s.shape[:-1] + (1,))
    p = jax.nn.softmax(jnp.concatenate([s, sink_col], axis=-1), axis=-1)[..., :-1].astype(v.dtype)
    o = jnp.einsum('bnkgqs,bnskd->bnqkgd', p, vw)
    return o.reshape(B, T, KV * G * hd)


def encoder_layer(x, c, w_ada, b_ada, w_in, q_norm_a, k_norm_a, sink_b, w_br_a, w_br_b, w_o,
                  ln1_g, ln1_b, w_ffn_gate, w_ffn_up, w_ffn_down, ln2_g, ln2_b):
    B, T, _ = x.shape
    mod = (jax.nn.silu(c) @ w_ada + b_ada).reshape(B, N_MOD, D_MODEL)[:, :, None, :]
    sh1, sc1, g1, sh2, sc2, g2 = [mod[:, i] for i in range(N_MOD)]

    h = layer_norm(x) * (1 + sc1) + sh1
    proj = h @ w_in
    qa, ka, va, qb, kb, vb, ga, gb = jnp.split(proj, SPLITS, axis=-1)

    cr, sr, cc, sc = axial_rope_tables(T)
    qa = axial_rope(rms_norm(qa.reshape(B, T, HA, HEAD_DIM), q_norm_a), cr, sr, cc, sc)
    ka = axial_rope(rms_norm(ka.reshape(B, T, KVA, HEAD_DIM), k_norm_a), cr, sr, cc, sc)
    ya = global_attention(qa.reshape(B, T, KVA, GA, HEAD_DIM), ka, va.reshape(B, T, KVA, HEAD_DIM))

    yb = window_attention(qb.reshape(B, T, KVB, GB, HEAD_DIM), kb.reshape(B, T, KVB, HEAD_DIM),
                          vb.reshape(B, T, KVB, HEAD_DIM), sink_b.reshape(KVB, GB))

    merged = jax.nn.sigmoid(ga) * (ya @ w_br_a) + jax.nn.sigmoid(gb) * (yb @ w_br_b)
    x = layer_norm(ALPHA * x + g1 * (merged @ w_o), ln1_g, ln1_b)

    h = layer_norm(x) * (1 + sc2) + sh2
    f = (jax.nn.silu(h @ w_ffn_gate) * (h @ w_ffn_up)) @ w_ffn_down
    return layer_norm(ALPHA * x + g2 * f, ln2_g, ln2_b)


def setup_inputs(seed: int = 0) -> dict:
    key = jax.random.key(seed)
    ks = jax.random.split(key, 24)
    f32 = jnp.float32

    def w(k, shape, fan_in, scale=1.0):
        return jax.random.normal(k, shape, f32) * (scale * fan_in ** -0.5)

    col_scale = jnp.concatenate([
        jnp.ones((QA_W + KVA_W,), f32), jnp.full((KVA_W,), BETA, f32),
        jnp.ones((QB_W + KVB_W,), f32), jnp.full((KVB_W,), BETA, f32),
        jnp.ones((2 * D_MODEL,), f32)])
    return {
        "x_prompt": jax.random.normal(ks[0], (BATCH, SEQ, D_MODEL), f32),
        "x_sample": jax.random.normal(ks[1], (DEC_BATCH, DEC_SEQ, D_MODEL), f32),
        "c_prompt": jax.random.normal(ks[2], (BATCH, D_MODEL), f32),
        "c_sample": jax.random.normal(ks[3], (DEC_BATCH, D_MODEL), f32),
        "w_ada": w(ks[4], (DEPTH, D_MODEL, N_MOD * D_MODEL), D_MODEL, 0.5),
        "b_ada": 0.02 * jax.random.normal(ks[5], (DEPTH, N_MOD * D_MODEL), f32),
        "w_in": w(ks[6], (DEPTH, D_MODEL, IN_W), D_MODEL) * col_scale,
        "q_norm_a": 1.0 + 0.05 * jax.random.normal(ks[7], (DEPTH, HEAD_DIM), f32),
        "k_norm_a": 1.0 + 0.05 * jax.random.normal(ks[8], (DEPTH, HEAD_DIM), f32),
        "sink_b": 0.5 * jax.random.normal(ks[9], (DEPTH, HB), f32),
        "w_br_a": w(ks[10], (DEPTH, QA_W, D_MODEL), QA_W, BETA),
        "w_br_b": w(ks[11], (DEPTH, QB_W, D_MODEL), QB_W, BETA),
        "w_o": w(ks[12], (DEPTH, D_MODEL, D_MODEL), D_MODEL, BETA),
        "ln1_g": 1.0 + 0.05 * jax.random.normal(ks[13], (DEPTH, D_MODEL), f32),
        "ln1_b": 0.02 * jax.random.normal(ks[14], (DEPTH, D_MODEL), f32),
        "w_ffn_gate": w(ks[15], (DEPTH, D_MODEL, D_FF), D_MODEL),
        "w_ffn_up": w(ks[16], (DEPTH, D_MODEL, D_FF), D_MODEL, BETA),
        "w_ffn_down": w(ks[17], (DEPTH, D_FF, D_MODEL), D_FF, BETA),
        "ln2_g": 1.0 + 0.05 * jax.random.normal(ks[18], (DEPTH, D_MODEL), f32),
        "ln2_b": 0.02 * jax.random.normal(ks[19], (DEPTH, D_MODEL), f32),
    }


def reference(x_prompt, x_sample, c_prompt, c_sample, w_ada, b_ada, w_in, q_norm_a, k_norm_a, sink_b,
              w_br_a, w_br_b, w_o, ln1_g, ln1_b, w_ffn_gate, w_ffn_up, w_ffn_down, ln2_g, ln2_b):
    y_prompt = x_prompt
    y_sample = x_sample
    for l in range(DEPTH):
        p = (w_ada[l], b_ada[l], w_in[l], q_norm_a[l], k_norm_a[l], sink_b[l], w_br_a[l], w_br_b[l], w_o[l],
             ln1_g[l], ln1_b[l], w_ffn_gate[l], w_ffn_up[l], w_ffn_down[l], ln2_g[l], ln2_b[l])
        y_prompt = encoder_layer(y_prompt, c_prompt, *p)
        y_sample = encoder_layer(y_sample, c_sample, *p)
    return (y_prompt, y_sample)
```

```cpp
#include <hip/hip_runtime.h>
#include <hip/hip_bf16.h>
#include <cstdio>
#include <cstdint>

#ifndef MK_N_LAUNCHES
#define MK_N_LAUNCHES 1
#endif
constexpr int N_PHASES = 11;
constexpr int N_LAUNCHES = MK_N_LAUNCHES;
constexpr int NWAVES = 8;

constexpr int DM = 4096, SEQ_P = 8192, SEQ_S = 4096, NB_S = 4, NBATCH = 5;
constexpr int M = SEQ_P + NB_S * SEQ_S;
constexpr int HD = 128, NHA = 16, NKVA = 4, NHB = 16, NKVB = 4;
constexpr int C_QA = 0, C_KA = 2048, C_VA = 2560, C_QB = 3072, C_KB = 5120, C_VB = 5632, C_GA = 6144, C_GB = 10240, IN_W = 14336;
constexpr int DFF = 11008, NMOD = 6;
constexpr int GATE_B0 = C_GA * 2;
constexpr float ALPHA = 1.189207115002721f, LN_EPS = 1e-5f, RMS_EPS = 1e-6f;
constexpr float ATT_SCALE = 0.088388347648318440f;
constexpr int L_H1 = 3, L_WIN = 9, L_Y = 5, L_WBR = 9, L_MG = 6, L_WO = 10, L_QK = 4;
constexpr float Q_PRE = ATT_SCALE * 1.4426950408889634f * 8.f;
constexpr int e8m0x4(int L) { return (127 - L) * 0x01010101; }

constexpr size_t MiB = 1u << 20;
constexpr size_t WS_CTL = 0, CTL_ZERO_BYTES = 1 * MiB;
constexpr size_t WS_MOD = 1 * MiB;
constexpr size_t WS_ROPE = 1 * MiB + 512 * 1024;
constexpr size_t WS_RSC = 1 * MiB + 640 * 1024;
constexpr size_t WS_CSC = 1 * MiB + 768 * 1024;
constexpr int CW_CMAX = 16384;
constexpr size_t WS_WIN = 2 * MiB;
constexpr size_t WS_WBR = WS_WIN + 112 * MiB;
constexpr size_t WS_WO = WS_WBR + 32 * MiB;
constexpr size_t WS_WGU = WS_WO + 32 * MiB;
constexpr size_t WS_WD = WS_WGU + 172 * MiB;
constexpr size_t WS_H = WS_WD + 86 * MiB;
constexpr size_t WS_Y = WS_H + 192 * MiB;
constexpr size_t WS_P = WS_Y + 96 * MiB;
constexpr size_t WS_QA8 = WS_P + 672 * MiB;
constexpr size_t WS_KA8 = WS_QA8 + 48 * MiB;
constexpr size_t WS_VT8 = WS_KA8 + 12 * MiB;
constexpr size_t WS_QB8 = WS_VT8 + 12 * MiB, WS_KB8 = WS_QB8 + 48 * MiB, WS_VTB8 = WS_KB8 + 12 * MiB;
constexpr size_t WS_END = WS_VTB8 + 12 * MiB;
static_assert((size_t)IN_W * DM * 2 <= 112 * MiB && (size_t)2 * DFF * DM * 2 <= 172 * MiB && (size_t)DM * DFF * 2 <= 86 * MiB && (size_t)M * IN_W * 2 <= 672 * MiB, "ws map");
constexpr int CW_TMO = 0, CW_BAR = 4096;

constexpr int RING_BYTES = 131072, LDSCTL_OFF = RING_BYTES, MISC_OFF = LDSCTL_OFF + 320, LDS_BYTES = 147456;

#define GAS __attribute__((address_space(1)))
#define LAS __attribute__((address_space(3)))
typedef unsigned short bf16;
typedef unsigned v4u __attribute__((ext_vector_type(4)));
typedef unsigned v2u __attribute__((ext_vector_type(2)));
typedef float f32x4 __attribute__((ext_vector_type(4)));
typedef float f32x2 __attribute__((ext_vector_type(2)));
typedef float f32x16 __attribute__((ext_vector_type(16)));
typedef short bf16x8 __attribute__((ext_vector_type(8)));
typedef short s16x4 __attribute__((ext_vector_type(4)));
typedef GAS unsigned gu32;
#define RLX_AGENT __ATOMIC_RELAXED, __HIP_MEMORY_SCOPE_AGENT
#define LDS_WAIT() asm volatile("s_waitcnt lgkmcnt(0)" ::: "memory")
#define VM_WAIT() asm volatile("s_waitcnt vmcnt(0)" ::: "memory")
__device__ __forceinline__ unsigned cvt_pk_bf16(float lo, float hi) { unsigned r; asm volatile("v_cvt_pk_bf16_f32 %0, %1, %2" : "=v"(r) : "v"(lo), "v"(hi)); return r; }
__device__ __forceinline__ float clamp448(float x) { return __builtin_amdgcn_fmed3f(x, -448.f, 448.f); }
__device__ __forceinline__ unsigned pk4_fp8(float a, float b, float c, float d) {
    int w = 0; w = __builtin_amdgcn_cvt_pk_fp8_f32(clamp448(a), clamp448(b), w, false); w = __builtin_amdgcn_cvt_pk_fp8_f32(clamp448(c), clamp448(d), w, true); return (unsigned)w; }
typedef _Float16 h16x2 __attribute__((ext_vector_type(2)));
__device__ __forceinline__ unsigned pk_h2(float a, float b) { const h16x2 h = {(_Float16)a, (_Float16)b}; return __builtin_bit_cast(unsigned, h); }
__device__ __forceinline__ float h_lo(unsigned w) { return (float)__builtin_bit_cast(h16x2, w)[0]; }
__device__ __forceinline__ float h_hi(unsigned w) { return (float)__builtin_bit_cast(h16x2, w)[1]; }
__device__ __forceinline__ unsigned pk4_gate(float a, float b, float c, float d) { unsigned w = 0;
    w = __builtin_amdgcn_cvt_pk_u8_f32(a * 256.f - 0.5f, 0, w); w = __builtin_amdgcn_cvt_pk_u8_f32(b * 256.f - 0.5f, 1, w); w = __builtin_amdgcn_cvt_pk_u8_f32(c * 256.f - 0.5f, 2, w); w = __builtin_amdgcn_cvt_pk_u8_f32(d * 256.f - 0.5f, 3, w); return w; }
template <int K> __device__ __forceinline__ float gate_f(unsigned w) { const float q = (float)((w >> (8 * K)) & 0xffu);
    return q * (1.f / 256.f) + (1.f / 512.f); }
__device__ __forceinline__ float bf_lo(unsigned w) { return __uint_as_float(w << 16); }
__device__ __forceinline__ float bf_hi(unsigned w) { return __uint_as_float(w & 0xffff0000u); }
__device__ __forceinline__ float sigmoidf_(float x) { return __builtin_amdgcn_rcpf(1.0f + __builtin_amdgcn_exp2f(-1.4426950408889634f * x)); }

__device__ __forceinline__ int kpos(int kappa) { const int k5 = kappa & 31; return 32 * ((k5 >> 2) & 1) + 16 * (kappa >> 5) + (k5 & 3) + 4 * (k5 >> 3); }
__device__ __forceinline__ int tid_fresh() { int t = threadIdx.x; asm volatile("" : "+v"(t)); return t; }

namespace pg8 {
constexpr int BM = 256, BK = 64, HALF = 128, HTB = HALF * BK * 2, STAGE_BYTES = 8 * HTB, NXCD = 8, WGM = 8;
__host__ __device__ __forceinline__ int lds_byte(int r, int c) { const int st = (r >> 4) * 2 + (c >> 5), rr = r & 15, cc = c & 31, ob = rr * 64 + cc * 2; return st * 1024 + (ob ^ (((ob >> 9) & 1) << 5)); }
__host__ __device__ __forceinline__ void stage_rc(int b, int& R, int& C) { const int st = b / 1024, sb = b % 1024, swz = sb ^ (((sb >> 9) & 1) << 5); R = (st >> 1) * 16 + swz / 64; C = (st & 1) * 32 + (swz % 64) / 2; }
__host__ __device__ __forceinline__ int perm32(int rho) { const int n = rho >> 4, i = rho & 15; return 8 * (i >> 2) + 4 * n + (i & 3); }

struct Unit { int pm, pn, kh; };
struct Gemm { const void* A; const void* Bt; int lda, ldb, kbytes, khoff; int sa, sb; };

struct StaticOrder {
    int nM, nN, nwg, G, c, wgm;
    __device__ void init(int M_, int N_, int G_, int c_, int wgm_ = WGM) { nM = M_ / BM; nN = N_ / BM; nwg = nM * nN; G = G_; c = c_; wgm = wgm_; }
    __device__ bool tile(int i, Unit& u) const {
        const long L = (long)i * G + c; if (L >= nwg) return false;
        int wgid = (int)L; { const int q = nwg / NXCD, r = nwg % NXCD, xcd = wgid % NXCD, off = wgid / NXCD; wgid = (xcd < r ? xcd * (q + 1) : r * (q + 1) + (xcd - r) * q) + off; }
        const int nig = wgm * nN, gid = wgid / nig, fm = gid * wgm, gsz = (nM - fm) < wgm ? (nM - fm) : wgm;
        u.pm = fm + ((wgid % nig) % gsz); u.pn = (wgid % nig) / gsz; u.kh = 0; return true;
    }
    __device__ bool next(int i, Unit& u) const { return tile(i, u); }
};
struct PairedOrder : StaticOrder {
    __device__ bool next(int i, Unit& u) const { const bool ok = tile(i >> 1, u); u.kh = i & 1; return ok; }
};

typedef f32x4 Acc[2][2][4][2];
typedef int v4i __attribute__((ext_vector_type(4)));
typedef int v8i __attribute__((ext_vector_type(8)));

struct EpiProj {
    static constexpr bool PERM = true, PAIRED = false;
    bf16* O; const float* qn; const float* kn; const float* rope; LAS float* xs;
    unsigned char* qa8; unsigned char* ka8; unsigned char* vt8; unsigned char* qb8; unsigned char* kb8; unsigned char* vtb8;
    __device__ __forceinline__ void operator()(const Acc& acc, const Unit& u, int wr, int wc, int fr, int fq) const {
        const int row0 = u.pm * BM + wr * 64 + fr;
        if (u.pn < 10) {
            const int p = wc >> 1, i0 = 16 * (wc & 1) + 4 * fq; const float* gn = (u.pn < 8 ? qn : kn) + 64 * p + i0;
            const f32x4 g1 = *(const f32x4*)gn, g2 = *(const f32x4*)(gn + 32);
#pragma unroll
            for (int ai = 0; ai < 2; ++ai)
#pragma unroll
                for (int m = 0; m < 4; ++m)
#pragma unroll
                    for (int bj = 0; bj < 2; ++bj) { const f32x4 v0 = acc[ai][bj][m][0], v1 = acc[ai][bj][m][1];
                        float ss = (v0[0] * v0[0] + v0[1] * v0[1]) + (v0[2] * v0[2] + v0[3] * v0[3]) + (v1[0] * v1[0] + v1[1] * v1[1]) + (v1[2] * v1[2] + v1[3] * v1[3]);
                        ss += __shfl_xor(ss, 16); ss += __shfl_xor(ss, 32);
                        if (fq == 0) xs[((ai * HALF + wr * 64 + m * 16 + fr) * 2 + bj) * 4 + wc] = ss; }
            asm volatile("s_waitcnt lgkmcnt(0)" ::: "memory"); __builtin_amdgcn_s_barrier(); asm volatile("" ::: "memory");
            const float* tab = rope + (p ? 8192 : 0); const int sin_off = p ? 2048 : 4096;
#pragma unroll
            for (int ai = 0; ai < 2; ++ai)
#pragma unroll
                for (int m = 0; m < 4; ++m) { const int r = row0 + ai * HALF + m * 16; const int t = r < SEQ_P ? r : (r - SEQ_P) & (SEQ_S - 1);
                    const float* tp = tab + (p ? (t & 63) : (t >> 6)) * 32 + i0; const f32x4 cs = *(const f32x4*)tp, sn = *(const f32x4*)(tp + sin_off);
#pragma unroll
                    for (int bj = 0; bj < 2; ++bj) { unsigned char* dst = (u.pn < 8 ? qa8 + (size_t)r * 2048 + (2 * u.pn + bj) * HD : ka8 + (size_t)r * 512 + (2 * (u.pn - 8) + bj) * HD) + 64 * p + i0; const f32x4 q4 = *(const LAS f32x4*)(xs + ((ai * HALF + wr * 64 + m * 16 + fr) * 2 + bj) * 4);
                        const float rs = 1.0f / sqrtf(((q4[0] + q4[1]) + (q4[2] + q4[3])) * (1.0f / HD) + RMS_EPS);
                        const f32x4 x1 = acc[ai][bj][m][0] * rs * g1, x2 = acc[ai][bj][m][1] * rs * g2;
                        const f32x4 y1 = x1 * cs - x2 * sn, y2 = x2 * cs + x1 * sn;
                        const float SC = (float)(1 << L_QK) * (u.pn < 8 ? Q_PRE : 1.0f);
                        *(unsigned*)dst = pk4_fp8(y1[0] * SC, y1[1] * SC, y1[2] * SC, y1[3] * SC); *(unsigned*)(dst + 32) = pk4_fp8(y2[0] * SC, y2[1] * SC, y2[2] * SC, y2[3] * SC); } }
            return;
        }
        if (u.pn == 10 || u.pn == 11 || u.pn == 22 || u.pn == 23) {
            unsigned char* const vt = u.pn < 12 ? vt8 : vtb8; const int h0 = 2 * (u.pn < 12 ? u.pn - 10 : u.pn - 22);
            constexpr float SC = (float)(1 << L_QK);
#pragma unroll
            for (int ai = 0; ai < 2; ++ai)
#pragma unroll
                for (int m = 0; m < 4; ++m) { const int r = row0 + ai * HALF + m * 16; const int gb = r >> 6, pos = kpos(r & 63);
#pragma unroll
                    for (int bj = 0; bj < 2; ++bj) { unsigned char* vb = vt + ((size_t)(gb * 4 + h0 + bj) * HD + wc * 32 + 8 * fq) * 64 + pos;
                        const f32x4 v0 = acc[ai][bj][m][0] * SC, v1 = acc[ai][bj][m][1] * SC; const unsigned w0 = pk4_fp8(v0[0], v0[1], v0[2], v0[3]), w1 = pk4_fp8(v1[0], v1[1], v1[2], v1[3]);
#pragma unroll
                        for (int e = 0; e < 4; ++e) { vb[e * 64] = (unsigned char)(w0 >> (8 * e)); vb[(4 + e) * 64] = (unsigned char)(w1 >> (8 * e)); } } }
            return;
        }
        const int col0 = u.pn * BM + wc * 32 + 8 * fq; const bool sig = u.pn * BM >= C_GA;
        if (!sig) {
            const bool isq = u.pn < 20; const float SC = (float)(1 << L_QK) * (isq ? Q_PRE : 1.0f);
#pragma unroll
            for (int ai = 0; ai < 2; ++ai)
#pragma unroll
                for (int m = 0; m < 4; ++m) { const size_t r = (size_t)(row0 + ai * HALF + m * 16);
                    unsigned char* dst = isq ? qb8 + r * 2048 + (col0 - C_QB) : kb8 + r * 512 + (col0 - C_KB);
#pragma unroll
                    for (int bj = 0; bj < 2; ++bj) { const f32x4 v0 = acc[ai][bj][m][0] * SC, v1 = acc[ai][bj][m][1] * SC;
                        v2u w; w.x = pk4_fp8(v0[0], v0[1], v0[2], v0[3]); w.y = pk4_fp8(v1[0], v1[1], v1[2], v1[3]); *(v2u*)(dst + bj * HALF) = w; } }
            return;
        }
#pragma unroll
        for (int ai = 0; ai < 2; ++ai)
#pragma unroll
            for (int m = 0; m < 4; ++m) { bf16* rowp = O + (size_t)(row0 + ai * HALF + m * 16) * IN_W + col0;
#pragma unroll
                for (int bj = 0; bj < 2; ++bj) { f32x4 v0 = acc[ai][bj][m][0], v1 = acc[ai][bj][m][1];
                    if (sig) {
#pragma unroll
                        for (int e = 0; e < 4; ++e) { v0[e] = sigmoidf_(v0[e]); v1[e] = sigmoidf_(v1[e]); }
                        v2u g; g.x = pk4_gate(v0[0], v0[1], v0[2], v0[3]); g.y = pk4_gate(v1[0], v1[1], v1[2], v1[3]);
                        *(v2u*)((unsigned char*)(rowp - col0) + GATE_B0 + (col0 - C_GA) + bj * HALF) = g; }
                    else { v4u w; w.x = cvt_pk_bf16(v0[0], v0[1]); w.y = cvt_pk_bf16(v0[2], v0[3]); w.z = cvt_pk_bf16(v1[0], v1[1]); w.w = cvt_pk_bf16(v1[2], v1[3]);
                        *(v4u*)(rowp + bj * HALF) = w; } } }
    }
};
struct EpiMerge {
    static constexpr bool PERM = true, PAIRED = true;
    const bf16* P; unsigned char* O;
    __device__ __forceinline__ void mid(Acc& acc, const Unit& u, int wr, int wc, int fr, int fq) const {
        const int row0 = u.pm * BM + wr * 64 + fr, col0 = u.pn * BM + wc * 32 + 8 * fq;
#pragma unroll
        for (int ai = 0; ai < 2; ++ai)
#pragma unroll
            for (int m = 0; m < 4; ++m) { const unsigned char* gp = (const unsigned char*)(P + (size_t)(row0 + ai * HALF + m * 16) * IN_W) + GATE_B0 + col0;
#pragma unroll
                for (int bj = 0; bj < 2; ++bj) { const v2u a = *(const v2u*)(gp + bj * HALF), b = *(const v2u*)(gp + DM + bj * HALF);
#define GM_(n, e, AW, BW, K) acc[ai][bj][m][n][e] *= gate_f<K>(AW) * __builtin_amdgcn_rcpf(gate_f<K>(BW))
                    GM_(0, 0, a.x, b.x, 0); GM_(0, 1, a.x, b.x, 1); GM_(0, 2, a.x, b.x, 2); GM_(0, 3, a.x, b.x, 3); GM_(1, 0, a.y, b.y, 0); GM_(1, 1, a.y, b.y, 1); GM_(1, 2, a.y, b.y, 2); GM_(1, 3, a.y, b.y, 3);
#undef GM_
                } }
    }
    __device__ __forceinline__ void operator()(const Acc& acc, const Unit& u, int wr, int wc, int fr, int fq) const {
        const int row0 = u.pm * BM + wr * 64 + fr, col0 = u.pn * BM + wc * 32 + 8 * fq;
        v2u gb[2][4][2];
#pragma unroll
        for (int ai = 0; ai < 2; ++ai)
#pragma unroll
            for (int m = 0; m < 4; ++m) { const size_t r = (size_t)(row0 + ai * HALF + m * 16);
#pragma unroll
                for (int bj = 0; bj < 2; ++bj) gb[ai][m][bj] = *(const v2u*)((const unsigned char*)(P + r * IN_W) + GATE_B0 + DM + col0 + bj * HALF); }
        asm volatile("" ::: "memory");
#pragma unroll
        for (int ai = 0; ai < 2; ++ai)
#pragma unroll
            for (int m = 0; m < 4; ++m) { const size_t r = (size_t)(row0 + ai * HALF + m * 16);
#pragma unroll
                for (int bj = 0; bj < 2; ++bj) { const v2u b = gb[ai][m][bj];
                    const float s[8] = {gate_f<0>(b.x), gate_f<1>(b.x), gate_f<2>(b.x), gate_f<3>(b.x), gate_f<0>(b.y), gate_f<1>(b.y), gate_f<2>(b.y), gate_f<3>(b.y)};
                    const f32x4 v0 = acc[ai][bj][m][0], v1 = acc[ai][bj][m][1]; constexpr float SC = (float)(1 << L_MG);
                    v2u w; w.x = pk4_fp8(v0[0] * s[0] * SC, v0[1] * s[1] * SC, v0[2] * s[2] * SC, v0[3] * s[3] * SC); w.y = pk4_fp8(v1[0] * s[4] * SC, v1[1] * s[5] * SC, v1[2] * s[6] * SC, v1[3] * s[7] * SC);
                    *(v2u*)(O + r * DM + col0 + bj * HALF) = w; } }
    }
};
template <bool XH> struct EpiRes {
    static constexpr bool PERM = true, PAIRED = false;
    const float* xp; const float* xs; const unsigned short* xh; unsigned short* out; const float* gate;
    __device__ __forceinline__ void operator()(const Acc& acc, const Unit& u, int wr, int wc, int fr, int fq) const {
        const int row0 = u.pm * BM + wr * 64 + fr, col0 = u.pn * BM + wc * 32 + 8 * fq;
        const int b = u.pm < 32 ? 0 : 1 + ((u.pm - 32) >> 4);
        const float* xb = u.pm < 32 ? xp : xs - (size_t)SEQ_P * DM;
        const float* gp = gate + (size_t)b * NMOD * DM + col0;
        f32x4 gv[2][2];
#pragma unroll
        for (int bj = 0; bj < 2; ++bj)
#pragma unroll
            for (int n = 0; n < 2; ++n) gv[bj][n] = *(const f32x4*)(gp + bj * HALF + n * 4);
#pragma unroll
        for (int ai = 0; ai < 2; ++ai) {
            f32x4 xv[4][2][2]; v4u hv[4][2];
#pragma unroll
            for (int m = 0; m < 4; ++m) { const size_t off = (size_t)(row0 + ai * HALF + m * 16) * DM + col0;
#pragma unroll
                for (int bj = 0; bj < 2; ++bj) {
                    if constexpr (XH) hv[m][bj] = *(const v4u*)(xh + off + bj * HALF);
                    else { xv[m][bj][0] = *(const f32x4*)(xb + off + bj * HALF); xv[m][bj][1] = *(const f32x4*)(xb + off + bj * HALF + 4); } } }
            asm volatile("" ::: "memory");
#pragma unroll
            for (int m = 0; m < 4; ++m) { const size_t off = (size_t)(row0 + ai * HALF + m * 16) * DM + col0;
#pragma unroll
                for (int bj = 0; bj < 2; ++bj) { f32x4 x0, x1;
                    if constexpr (XH) { const v4u h = hv[m][bj]; x0 = (f32x4){h_lo(h.x), h_hi(h.x), h_lo(h.y), h_hi(h.y)}; x1 = (f32x4){h_lo(h.z), h_hi(h.z), h_lo(h.w), h_hi(h.w)}; }
                    else { x0 = xv[m][bj][0]; x1 = xv[m][bj][1]; }
                    const f32x4 t0 = x0 * ALPHA + gv[bj][0] * acc[ai][bj][m][0], t1 = x1 * ALPHA + gv[bj][1] * acc[ai][bj][m][1];
                    v4u w; w.x = pk_h2(t0[0], t0[1]); w.y = pk_h2(t0[2], t0[3]); w.z = pk_h2(t1[0], t1[1]); w.w = pk_h2(t1[2], t1[3]);
                    *(v4u*)(out + off + bj * HALF) = w; } }
            asm volatile("" ::: "memory");
        }
    }
};
struct EpiSwiglu {
    static constexpr bool PERM = true, PAIRED = false;
    bf16* O; const float* rs; const float* cs;
    __device__ __forceinline__ void operator()(const Acc& acc, const Unit& u, int wr, int wc, int fr, int fq) const {
        const int row0 = u.pm * BM + wr * 64 + fr, col0 = u.pn * HALF + wc * 32 + 8 * fq;
        const float* cp = cs + u.pn * BM + wc * 32 + 8 * fq;
        const f32x4 cg0 = *(const f32x4*)cp, cg1 = *(const f32x4*)(cp + 4), cu0 = *(const f32x4*)(cp + HALF), cu1 = *(const f32x4*)(cp + HALF + 4);
        float rsv[2][4];
#pragma unroll
        for (int ai = 0; ai < 2; ++ai)
#pragma unroll
            for (int m = 0; m < 4; ++m) rsv[ai][m] = rs[row0 + ai * HALF + m * 16];
        asm volatile("" ::: "memory");
#pragma unroll
        for (int ai = 0; ai < 2; ++ai)
#pragma unroll
            for (int m = 0; m < 4; ++m) { float v[8]; const int r = row0 + ai * HALF + m * 16; const float rsc = rsv[ai][m];
#pragma unroll
                for (int n = 0; n < 2; ++n)
#pragma unroll
                    for (int e = 0; e < 4; ++e) { const float g = (float)__float_as_int(acc[ai][0][m][n][e]) * (rsc * (n ? cg1[e] : cg0[e])), up = (float)__float_as_int(acc[ai][1][m][n][e]) * (rsc * (n ? cu1[e] : cu0[e])); v[n * 4 + e] = g * sigmoidf_(g) * up; }
                v4u w; w.x = cvt_pk_bf16(v[0], v[1]); w.y = cvt_pk_bf16(v[2], v[3]); w.z = cvt_pk_bf16(v[4], v[5]); w.w = cvt_pk_bf16(v[6], v[7]);
                *(v4u*)(O + (size_t)r * DFF + col0) = w; }
    }
};

template <class Epi, bool INT> struct EpiHalf {
    static constexpr bool PERM = Epi::PERM, PAIRED = true; Epi e;
    __device__ __forceinline__ void mid(Acc&, const Unit&, int, int, int, int) const {}
    __device__ __forceinline__ void operator()(Acc& acc, const Unit& u, int wr, int wc, int fr, int fq) const {
#pragma unroll
        for (int a = 0; a < 2; ++a)
#pragma unroll
            for (int b = 0; b < 2; ++b)
#pragma unroll
                for (int m = 0; m < 4; ++m)
#pragma unroll
                    for (int n = 0; n < 2; ++n)
#pragma unroll
                        for (int q = 0; q < 4; ++q) { if (INT) acc[a][b][m][n][q] = __int_as_float(__float_as_int(acc[a][b][m][n][q]) >> 1); else acc[a][b][m][n][q] *= 0.5f; }
        e(acc, u, wr, wc, fr, fq);
    }
};
template <class Epi, class Sched, int GM>
__device__ __forceinline__ void gemm_phase(LAS unsigned char* lds, const Gemm g, const Sched& S, Epi E) {
    const int tid = tid_fresh(), wid = __builtin_amdgcn_readfirstlane(tid >> 6), lane = tid & 63, wr = wid >> 2, wc = wid & 3, fr = lane & 15, fq = lane >> 4;
    constexpr bool F8 = GM == 1;
    const int nt = g.kbytes / (BK * 2);
    const int sclA = g.sa, sclB = g.sb;
    unsigned voffA[2], voffB[2];
#pragma unroll
    for (int i = 0; i < 2; ++i) { int R, C; stage_rc(tid * 16 + i * 8192, R, C); const int Rb = Epi::PERM ? ((R & ~31) + perm32(R & 31)) : R;
        voffA[i] = (unsigned)(R * g.lda + C * 2); voffB[i] = (unsigned)(Rb * g.ldb + C * 2); }
    const size_t kstep = (size_t)(BK * 2);
    const size_t hstepA = (size_t)HALF * g.lda, hstepB = (size_t)HALF * g.ldb;
    const unsigned ldsw = (unsigned)wid * 1024u;
    const int aoff = lds_byte(wr * 64 + fr, fq * 8), boff = lds_byte(wc * 32 + fr, fq * 8);
#define PG8_SA(b, h) (((b) * 2 + (h)) * HTB)
#define PG8_SB(b, h) ((4 + (b) * 2 + (h)) * HTB)
#define PG8_STAGE(bufoff, gbase, voff) do { _Pragma("unroll") for (int _i = 0; _i < 2; ++_i) \
        __builtin_amdgcn_global_load_lds((const unsigned*)((const char*)(gbase) + (voff)[_i]), (LAS unsigned*)(lds + (bufoff) + ldsw + _i * 8192), 16, 0, 0); } while (0)
#define PG8_CAT(p) __builtin_shufflevector(*(const LAS v4i*)(p), *(const LAS v4i*)((p) + 1024), 0, 1, 2, 3, 4, 5, 6, 7)
#define PG8_LDA(dst, b, h) do { if constexpr (F8) { _Pragma("unroll") for (int m = 0; m < 4; ++m) dst##8[m] = PG8_CAT(lds + PG8_SA(b, h) + aoff + m * 2048); } \
        else { _Pragma("unroll") for (int m = 0; m < 4; ++m) _Pragma("unroll") for (int k = 0; k < 2; ++k) dst[m][k] = *(const LAS bf16x8*)(lds + PG8_SA(b, h) + aoff + m * 2048 + k * 1024); } } while (0)
#define PG8_LDB(dst, b, h) do { if constexpr (F8) { _Pragma("unroll") for (int n = 0; n < 2; ++n) dst##8[n] = PG8_CAT(lds + PG8_SB(b, h) + boff + n * 2048); } \
        else { _Pragma("unroll") for (int n = 0; n < 2; ++n) _Pragma("unroll") for (int k = 0; k < 2; ++k) dst[n][k] = *(const LAS bf16x8*)(lds + PG8_SB(b, h) + boff + n * 2048 + k * 1024); } } while (0)
#define PG8_MMA(ai, bj, At, Bt) do { __builtin_amdgcn_s_setprio(1); if constexpr (F8) { _Pragma("unroll") for (int m = 0; m < 4; ++m) _Pragma("unroll") for (int n = 0; n < 2; ++n) \
            asm volatile("v_mfma_scale_f32_16x16x128_f8f6f4 %0, %1, %2, %0, %3, %4 op_sel_hi:[0,0,0]" : "+v"(acc[ai][bj][m][n]) : "v"(Bt##8[n]), "v"(At##8[m]), "v"(sclB), "v"(sclA)); } \
        else if constexpr (GM == 2) { _Pragma("unroll") for (int m = 0; m < 4; ++m) _Pragma("unroll") for (int n = 0; n < 2; ++n) _Pragma("unroll") for (int k = 0; k < 2; ++k) \
        acc[ai][bj][m][n] = __builtin_bit_cast(f32x4, __builtin_amdgcn_mfma_i32_16x16x64_i8(__builtin_bit_cast(v4i, Bt[n][k]), __builtin_bit_cast(v4i, At[m][k]), __builtin_bit_cast(v4i, acc[ai][bj][m][n]), 0, 0, 0)); } \
        else { _Pragma("unroll") for (int m = 0; m < 4; ++m) _Pragma("unroll") for (int n = 0; n < 2; ++n) _Pragma("unroll") for (int k = 0; k < 2; ++k) \
        acc[ai][bj][m][n] = __builtin_amdgcn_mfma_f32_16x16x32_bf16(Bt[n][k], At[m][k], acc[ai][bj][m][n], 0, 0, 0); } __builtin_amdgcn_s_setprio(0); } while (0)
#define PG8_WAIT_V(n) asm volatile("s_waitcnt vmcnt(" #n ")" ::: "memory")
#define PG8_WAIT_L(n) asm volatile("s_waitcnt lgkmcnt(" #n ")" ::: "memory")
#define PG8_BAR __builtin_amdgcn_s_barrier()
#define PG8_SCHED __builtin_amdgcn_sched_barrier(0)
#define PG8_UA(u) ((const char*)g.A + (size_t)(u).pm * 2 * hstepA + (size_t)(u).kh * g.khoff)
#define PG8_UB(u) ((const char*)g.Bt + (size_t)(u).pn * 2 * hstepB + (size_t)(u).kh * g.khoff)
    Unit cur, nxt; int ui = 0;
    if (!S.next(0, cur)) return;
    Acc acc;
#pragma unroll
    for (int a = 0; a < 2; ++a)
#pragma unroll
        for (int b = 0; b < 2; ++b)
#pragma unroll
            for (int m = 0; m < 4; ++m)
#pragma unroll
                for (int n = 0; n < 2; ++n) acc[a][b][m][n] = (f32x4){0.f, 0.f, 0.f, 0.f};
    bf16x8 At[4][2], B0[2][2], B1[2][2]; v8i At8[4], B08[2], B18[2];
    const char* cA = PG8_UA(cur); const char* cB = PG8_UB(cur);
    PG8_STAGE(PG8_SB(0, 0), cB, voffB); PG8_STAGE(PG8_SB(0, 1), cB + hstepB, voffB); PG8_STAGE(PG8_SA(0, 0), cA, voffA); PG8_STAGE(PG8_SA(0, 1), cA + hstepA, voffA);
    if (wr == 1) PG8_BAR;
    PG8_WAIT_V(2); PG8_BAR;
    PG8_STAGE(PG8_SB(1, 0), cB + kstep, voffB); PG8_STAGE(PG8_SA(1, 0), cA + kstep, voffA); PG8_STAGE(PG8_SB(1, 1), cB + hstepB + kstep, voffB);
    PG8_WAIT_V(6); PG8_BAR;
    for (;;) {
        const bool has_next = S.next(ui + 1, nxt);
        const char* nA = has_next ? PG8_UA(nxt) : cA; const char* nB = has_next ? PG8_UB(nxt) : cB;
        for (int t = 0; t < nt; t += 2) {
            const bool last = (t == nt - 2);
            const char* a1 = cA + (size_t)(t + 1) * kstep;
            const char* a2 = last ? nA : cA + (size_t)(t + 2) * kstep; const char* b2 = last ? nB : cB + (size_t)(t + 2) * kstep;
            const char* a3 = a2 + kstep; const char* b3 = b2 + kstep;
            PG8_LDB(B0, 0, 0); PG8_LDB(B1, 0, 1); PG8_SCHED; PG8_LDA(At, 0, 0); PG8_STAGE(PG8_SA(1, 1), a1 + hstepA, voffA);
            PG8_WAIT_V(8); PG8_WAIT_L(0); PG8_BAR; PG8_MMA(0, 0, At, B0); PG8_MMA(0, 1, At, B1); PG8_BAR; PG8_SCHED;
            PG8_LDA(At, 0, 1); PG8_STAGE(PG8_SB(0, 0), b2, voffB); PG8_STAGE(PG8_SB(0, 1), b2 + hstepB, voffB); PG8_STAGE(PG8_SA(0, 0), a2, voffA);
            PG8_WAIT_V(8); PG8_WAIT_L(0); PG8_BAR; PG8_MMA(1, 0, At, B0); PG8_MMA(1, 1, At, B1); PG8_BAR; PG8_SCHED;
            PG8_LDB(B0, 1, 0); PG8_LDB(B1, 1, 1); PG8_SCHED; PG8_LDA(At, 1, 0); PG8_STAGE(PG8_SA(0, 1), a2 + hstepA, voffA);
            PG8_WAIT_V(8); PG8_WAIT_L(0); PG8_BAR; PG8_MMA(0, 0, At, B0); PG8_MMA(0, 1, At, B1); PG8_BAR; PG8_SCHED;
            PG8_LDA(At, 1, 1); PG8_STAGE(PG8_SB(1, 0), b3, voffB); PG8_STAGE(PG8_SB(1, 1), b3 + hstepB, voffB); PG8_STAGE(PG8_SA(1, 0), a3, voffA);
            PG8_WAIT_V(8); PG8_WAIT_L(0); PG8_BAR; PG8_MMA(1, 0, At, B0); PG8_MMA(1, 1, At, B1); PG8_BAR; PG8_SCHED;
        }
        if constexpr (F8) asm volatile("s_nop 7\n\ts_nop 7\n\ts_nop 7" ::: "memory");
        if (wr == 0) PG8_BAR;
        bool keep = false;
        if constexpr (Epi::PAIRED) { if (cur.kh == 0) { E.mid(acc, cur, wr, wc, fr, fq); keep = true; } }
        if (!keep) E(acc, cur, wr, wc, fr, fq);
        if (!has_next) break;
        if (!keep) {
#pragma unroll
            for (int a = 0; a < 2; ++a)
#pragma unroll
                for (int b = 0; b < 2; ++b)
#pragma unroll
                    for (int m = 0; m < 4; ++m)
#pragma unroll
                        for (int n = 0; n < 2; ++n) acc[a][b][m][n] = (f32x4){0.f, 0.f, 0.f, 0.f};
        }
        cur = nxt; cA = nA; cB = nB; ++ui;
        if (wr == 1) PG8_BAR;
    }
    PG8_WAIT_V(0);
    PG8_BAR;
#undef PG8_SA
#undef PG8_SB
#undef PG8_STAGE
#undef PG8_LDA
#undef PG8_CAT
#undef PG8_LDB
#undef PG8_MMA
#undef PG8_WAIT_V
#undef PG8_WAIT_L
#undef PG8_BAR
#undef PG8_SCHED
#undef PG8_UA
#undef PG8_UB
}
}

namespace att {
constexpr int D = 128, NW = 8, QBLK = 32, KVBLK = 64;
constexpr float SCALE = ATT_SCALE, THR = 8.f;
constexpr int LDQ = IN_W, LDK = IN_W, LDO = DM;
constexpr int SHM_V = KVBLK * D * 2, SHM_K = KVBLK * D * 2, SHM_ATTN = 2 * SHM_V + 2 * SHM_K + NW * 64 * 4;
#define KSWZ(row, colB) ((row) * 256 + ((colB) ^ (((row) & 7) << 4)))
#define SBAR() __builtin_amdgcn_sched_barrier(0)
__device__ __forceinline__ int crow(int r, int hi) { return (r & 3) + 8 * (r >> 2) + 4 * hi; }
__device__ __forceinline__ void partialSM(f32x16& p0, f32x16& p1, float& m_reg, float& mn, float& alpha) {
  constexpr float C = SCALE * 1.4426950408889634f;
  float pmax = p0[0];
#pragma unroll
  for (int r = 1; r < 16; ++r) pmax = fmaxf(pmax, p0[r]);
#pragma unroll
  for (int r = 0; r < 16; ++r) pmax = fmaxf(pmax, p1[r]);
  { auto rr = __builtin_amdgcn_permlane32_swap(__float_as_uint(pmax), __float_as_uint(pmax), false, false);
    pmax = fmaxf(__uint_as_float(rr[0]), __uint_as_float(rr[1])); }
  if (__builtin_expect(__all(pmax - m_reg <= THR / SCALE), 1)) { mn = m_reg; alpha = 1.f; }
  else { mn = fmaxf(m_reg, pmax); alpha = __builtin_amdgcn_exp2f((m_reg - mn) * C); m_reg = mn; }
  float mnC = -mn * C;
#pragma unroll
  for (int r = 0; r < 16; ++r) p0[r] = fmaf(p0[r], C, mnC);
#pragma unroll
  for (int r = 0; r < 16; ++r) p1[r] = fmaf(p1[r], C, mnC);
#pragma unroll
  for (int r = 0; r < 16; ++r) p0[r] = __builtin_amdgcn_exp2f(p0[r]);
}
__device__ __forceinline__ void finishSM(f32x16& p0, f32x16& p1, float alpha, float& l_reg, bf16x8& pa0, bf16x8& pa1, bf16x8& pa2, bf16x8& pa3) {
#pragma unroll
  for (int r = 0; r < 16; ++r) p1[r] = __builtin_amdgcn_exp2f(p1[r]);
  float ps = 0;
#pragma unroll
  for (int r = 0; r < 16; ++r) ps += p0[r];
#pragma unroll
  for (int r = 0; r < 16; ++r) ps += p1[r];
  { auto rr = __builtin_amdgcn_permlane32_swap(__float_as_uint(ps), __float_as_uint(ps), false, false);
    ps = __uint_as_float(rr[0]) + __uint_as_float(rr[1]); }
  l_reg = l_reg * alpha + ps;
#define PK4(P, BASE, OUT) do { unsigned a0 = cvt_pk_bf16(P[BASE + 0], P[BASE + 1]), a1 = cvt_pk_bf16(P[BASE + 2], P[BASE + 3]);   \
    unsigned b0 = cvt_pk_bf16(P[BASE + 4], P[BASE + 5]), b1 = cvt_pk_bf16(P[BASE + 6], P[BASE + 7]);                              \
    auto r0 = __builtin_amdgcn_permlane32_swap(a0, b0, false, false); auto r1 = __builtin_amdgcn_permlane32_swap(a1, b1, false, false); \
    v4u w = {r0[0], r1[0], r0[1], r1[1]}; OUT = *reinterpret_cast<bf16x8*>(&w); } while (0)
  PK4(p0, 0, pa0); PK4(p0, 8, pa1); PK4(p1, 0, pa2); PK4(p1, 8, pa3);
#undef PK4
}
__device__ __forceinline__ void qkt(f32x16& p0, f32x16& p1, const char* Ks, const bf16x8* qr, int r32, int hi) {
  p0 = f32x16{}; p1 = f32x16{};
#pragma unroll
  for (int d0 = 0; d0 < 8; ++d0) { int cb = (d0 * 16 + hi * 8) * 2;
    bf16x8 b0 = *reinterpret_cast<const bf16x8*>(Ks + KSWZ(r32, cb));
    bf16x8 b1 = *reinterpret_cast<const bf16x8*>(Ks + KSWZ(32 + r32, cb));
    p0 = __builtin_amdgcn_mfma_f32_32x32x16_bf16(b0, qr[d0], p0, 0, 0, 0);
    p1 = __builtin_amdgcn_mfma_f32_32x32x16_bf16(b1, qr[d0], p1, 0, 0, 0); }
}
__device__ __forceinline__ void win_bias(f32x16& p0, f32x16& p1, int dq, float sl) {
  const float NEG = -__builtin_inff();
#pragma unroll
  for (int r = 0; r < 16; ++r) { const int c = (r & 3) + 8 * (r >> 2);
    const int d0 = dq - c, d1 = dq - c - 32; const int a0 = d0 < 0 ? -d0 : d0, a1 = d1 < 0 ? -d1 : d1;
    p0[r] = a0 <= 128 ? fmaf(-sl, (float)a0, p0[r]) : NEG;
    p1[r] = a1 <= 128 ? fmaf(-sl, (float)a1, p1[r]) : NEG; }
}
__device__ __forceinline__ int v_st(int k, int c) { const int kk = (k & ~0xC) | ((k & 4) << 1) | ((k & 8) >> 1); return ((kk >> 3) * 4 + (c >> 5)) * 512 + ((kk & 7) * 32 + (c & 31)) * 2; }
__device__ __forceinline__ int v_rd_base(int lane) { return ((lane & 3) << 3) | (((lane >> 2) & 3) << 6) | (((lane >> 4) & 1) << 5) | (((lane >> 5) & 1) << 8); }
constexpr int v_rd_off(int d0, int ks, int half) { return d0 * 512 + ks * 4096 + half * 2048; }
template <int OFF> __device__ __forceinline__ s16x4 tr_read(int vb) {
  s16x4 r; asm volatile("ds_read_b64_tr_b16 %0, %1 offset:%2" : "=&v"(r) : "v"(vb), "i"(OFF) : "memory"); return r;
}
template <int D0> __device__ __forceinline__ void pv_one(f32x16& od, int vb, bf16x8 pa0, bf16x8 pa1, bf16x8 pa2, bf16x8 pa3) {
  const s16x4 l0 = tr_read<v_rd_off(D0, 0, 0)>(vb), h0 = tr_read<v_rd_off(D0, 0, 1)>(vb), l1 = tr_read<v_rd_off(D0, 1, 0)>(vb), h1 = tr_read<v_rd_off(D0, 1, 1)>(vb);
  const s16x4 l2 = tr_read<v_rd_off(D0, 2, 0)>(vb), h2 = tr_read<v_rd_off(D0, 2, 1)>(vb), l3 = tr_read<v_rd_off(D0, 3, 0)>(vb), h3 = tr_read<v_rd_off(D0, 3, 1)>(vb);
  asm volatile("s_waitcnt lgkmcnt(0)" ::: "memory"); SBAR();
#define PK(L, H) (bf16x8){L[0], L[1], L[2], L[3], H[0], H[1], H[2], H[3]}
  od = __builtin_amdgcn_mfma_f32_32x32x16_bf16(PK(l0, h0), pa0, od, 0, 0, 0);
  od = __builtin_amdgcn_mfma_f32_32x32x16_bf16(PK(l1, h1), pa1, od, 0, 0, 0);
  od = __builtin_amdgcn_mfma_f32_32x32x16_bf16(PK(l2, h2), pa2, od, 0, 0, 0);
  od = __builtin_amdgcn_mfma_f32_32x32x16_bf16(PK(l3, h3), pa3, od, 0, 0, 0);
#undef PK
}
__device__ __forceinline__ void pv_d0(f32x16* o, int vb, bf16x8 pa0, bf16x8 pa1, bf16x8 pa2, bf16x8 pa3) {
  pv_one<0>(o[0], vb, pa0, pa1, pa2, pa3); pv_one<1>(o[1], vb, pa0, pa1, pa2, pa3); pv_one<2>(o[2], vb, pa0, pa1, pa2, pa3); pv_one<3>(o[3], vb, pa0, pa1, pa2, pa3);
}
template <int MODE, int SDEPTH>
__device__ __forceinline__ void attn_body(const bf16* __restrict__ Qb, const bf16* __restrict__ Kh, const bf16* __restrict__ Vh, unsigned char* __restrict__ Ob, int NT, char* lds, int qrel, float sl, float sink_raw) {
  const int tid = tid_fresh(), wid = tid >> 6, lane = tid & 63, r32 = lane & 31, hi = lane >> 5;
  char* V_lds = lds; char* K_lds = lds + 2 * SHM_V;
  float m_reg = MODE ? sink_raw : -1e30f, l_reg = MODE ? 1.f : 0.f; f32x16 o[4] = {}; bf16x8 qr[8];
  const int dq0 = qrel + wid * QBLK + r32 - 4 * hi;
  const bf16* Qw = Qb + (long)(wid * QBLK + r32) * LDQ + hi * 8;
#pragma unroll
  for (int d0 = 0; d0 < 8; ++d0) qr[d0] = *reinterpret_cast<const bf16x8*>(Qw + d0 * 16);
  const int sr = tid >> 4, sc = (tid & 15) * 8, vst0 = v_st(sr, sc), vst1 = v_st(32 + sr, sc);
  const int vb0 = (int)(uintptr_t)V_lds + v_rd_base(lane);
  struct { bf16x8 vs0, vs1, ks0, ks1; } sr_[SDEPTH];
#define SLOAD(i, k0) do { sr_[i].vs0 = *reinterpret_cast<const bf16x8*>(&Vh[(long)((k0) + sr) * LDK + sc]); sr_[i].vs1 = *reinterpret_cast<const bf16x8*>(&Vh[(long)((k0) + 32 + sr) * LDK + sc]); \
    sr_[i].ks0 = *reinterpret_cast<const bf16x8*>(&Kh[(long)((k0) + sr) * LDK + sc]); sr_[i].ks1 = *reinterpret_cast<const bf16x8*>(&Kh[(long)((k0) + 32 + sr) * LDK + sc]); } while (0)
#define SWRITE(b, i) do { *(bf16x8*)(V_lds + (b) * SHM_V + vst0) = sr_[i].vs0;          \
    *(bf16x8*)(V_lds + (b) * SHM_V + vst1) = sr_[i].vs1; int kc = sc * 2;               \
    *(bf16x8*)(K_lds + (b) * SHM_K + KSWZ(sr, kc)) = sr_[i].ks0;                       \
    *(bf16x8*)(K_lds + (b) * SHM_K + KSWZ(32 + sr, kc)) = sr_[i].ks1; } while (0)
#define SWAIT() do { if constexpr (SDEPTH == 2) asm volatile("s_waitcnt vmcnt(4)" ::: "memory"); else asm volatile("s_waitcnt vmcnt(0)" ::: "memory"); } while (0)
#define RESC(a) do { if (__any((a) < 1.f)) { _Pragma("unroll") for (int d = 0; d < 4; ++d) _Pragma("unroll") for (int r = 0; r < 16; ++r) o[d][r] *= (a); } } while (0)
#define WB(P0, P1, j) do { if (MODE) win_bias(P0, P1, dq0 - (j) * KVBLK, sl); } while (0)
  f32x16 pA0, pA1, pB0, pB1; float mnA, mnB, alA, alB; bf16x8 pa0, pa1, pa2, pa3;
  constexpr int SE = 0, SO = SDEPTH - 1;
  SLOAD(SE, 0); asm volatile("s_waitcnt vmcnt(0)" ::: "memory"); SWRITE(0, SE);
  if constexpr (SDEPTH == 1) SLOAD(SO, KVBLK);
  __syncthreads();
  qkt(pA0, pA1, K_lds, qr, r32, hi); WB(pA0, pA1, 0); partialSM(pA0, pA1, m_reg, mnA, alA);
  if constexpr (SDEPTH == 2) { SLOAD(SO, KVBLK); if (2 < NT) SLOAD(SE, 2 * KVBLK); }
  SWAIT(); SWRITE(1, SO); __syncthreads();
  for (int j = 1; j + 1 < NT; j += 2) {
    SBAR(); qkt(pB0, pB1, K_lds + SHM_K, qr, r32, hi);
    finishSM(pA0, pA1, alA, l_reg, pa0, pa1, pa2, pa3); SBAR();
    SLOAD(SO, (j + SDEPTH) * KVBLK); SBAR();
    pv_d0(o, vb0, pa0, pa1, pa2, pa3); WB(pB0, pB1, j); partialSM(pB0, pB1, m_reg, mnB, alB);
    __syncthreads(); SWAIT(); SWRITE(0, SE);
    RESC(alB); __syncthreads();
    SBAR(); qkt(pA0, pA1, K_lds, qr, r32, hi);
    finishSM(pB0, pB1, alB, l_reg, pa0, pa1, pa2, pa3); SBAR();
    if (SDEPTH == 1 || j + 3 < NT) SLOAD(SE, (j + 1 + SDEPTH) * KVBLK); SBAR();
    pv_d0(o, vb0 + (int)SHM_V, pa0, pa1, pa2, pa3); WB(pA0, pA1, j + 1); partialSM(pA0, pA1, m_reg, mnA, alA);
    __syncthreads(); SWAIT(); SWRITE(1, SO);
    RESC(alA); __syncthreads();
  }
  SBAR(); qkt(pB0, pB1, K_lds + SHM_K, qr, r32, hi);
  finishSM(pA0, pA1, alA, l_reg, pa0, pa1, pa2, pa3); SBAR();
  pv_d0(o, vb0, pa0, pa1, pa2, pa3); WB(pB0, pB1, NT - 1); partialSM(pB0, pB1, m_reg, mnB, alB);
  __syncthreads(); RESC(alB);
  finishSM(pB0, pB1, alB, l_reg, pa0, pa1, pa2, pa3); SBAR();
  pv_d0(o, vb0 + (int)SHM_V, pa0, pa1, pa2, pa3);
  { const float rl = __builtin_amdgcn_rcpf(l_reg) * (float)(1 << L_Y);
    unsigned char* Ow = Ob + (long)(wid * QBLK + r32) * LDO + 4 * hi;
#pragma unroll
    for (int d0 = 0; d0 < 4; ++d0)
#pragma unroll
      for (int g = 0; g < 4; ++g) *(unsigned*)(Ow + d0 * 32 + 8 * g) = pk4_fp8(o[d0][4 * g] * rl, o[d0][4 * g + 1] * rl, o[d0][4 * g + 2] * rl, o[d0][4 * g + 3] * rl); }
#undef SLOAD
#undef SWRITE
#undef SWAIT
#undef RESC
#undef WB
}
}


namespace att8 {
typedef int v4i __attribute__((ext_vector_type(4)));
typedef int v8i __attribute__((ext_vector_type(8)));
constexpr float SCALE = ATT_SCALE, THR = 3.f;
constexpr int TB = 8192;
constexpr int SC8 = (127 - L_QK) * 0x01010101;
constexpr int SC8Q = (127 - L_QK - 3) * 0x01010101;
constexpr float THR2 = THR * 1.4426950408889634f;
#define CAT8(p) __builtin_shufflevector(*(const v4i*)(p), *(const v4i*)((p) + 16), 0, 1, 2, 3, 4, 5, 6, 7)
__device__ __forceinline__ v8i cat8x(const char* base, int off) { return __builtin_shufflevector(*(const v4i*)(base + off), *(const v4i*)(base + (off ^ 16)), 0, 1, 2, 3, 4, 5, 6, 7); }
template <bool FIRST>
__device__ __forceinline__ void softmax8(f32x16& p0, f32x16& p1, f32x16& ci, f32x16& ls, f32x16* o, v8i& P8) {
  float pmax = p0[0];
#pragma unroll
  for (int r = 1; r < 16; ++r) pmax = fmaxf(pmax, p0[r]);
#pragma unroll
  for (int r = 0; r < 16; ++r) pmax = fmaxf(pmax, p1[r]);
  { auto rr = __builtin_amdgcn_permlane32_swap(__float_as_uint(pmax), __float_as_uint(pmax), false, false);
    pmax = fmaxf(__uint_as_float(rr[0]), __uint_as_float(rr[1])); }
  if (FIRST || !__all(pmax <= THR2 + (float)L_QK)) {
    const float d = FIRST ? pmax - (float)L_QK : fmaxf(pmax - (float)L_QK, 0.f);
#pragma unroll
    for (int r = 0; r < 16; ++r) { p0[r] -= d; p1[r] -= d; ci[r] -= d; }
    if (!FIRST) { const float alpha = __builtin_amdgcn_exp2f(-d);
#pragma unroll
      for (int r = 0; r < 16; ++r) ls[r] *= alpha;
#pragma unroll
      for (int db = 0; db < 4; ++db)
#pragma unroll
        for (int r = 0; r < 16; ++r) o[db][r] *= alpha; }
  }
#pragma unroll
  for (int r = 0; r < 16; ++r) { p0[r] = __builtin_amdgcn_exp2f(p0[r]); p1[r] = __builtin_amdgcn_exp2f(p1[r]); }
#pragma unroll
  for (int k = 0; k < 4; ++k) { int w = P8[k]; w = __builtin_amdgcn_cvt_pk_fp8_f32(p0[4 * k], p0[4 * k + 1], w, false); w = __builtin_amdgcn_cvt_pk_fp8_f32(p0[4 * k + 2], p0[4 * k + 3], w, true); P8[k] = w; }
#pragma unroll
  for (int k = 0; k < 4; ++k) { int w = P8[4 + k]; w = __builtin_amdgcn_cvt_pk_fp8_f32(p1[4 * k], p1[4 * k + 1], w, false); w = __builtin_amdgcn_cvt_pk_fp8_f32(p1[4 * k + 2], p1[4 * k + 3], w, true); P8[4 + k] = w; }
}
__device__ __forceinline__ void qkt8(f32x16& p0, f32x16& p1, const char* Kt, const v8i (&q8)[2], int ka0, int ka1, const f32x16& ci, const v8i& k00, const v8i& k10) {
  p0 = __builtin_amdgcn_mfma_scale_f32_32x32x64_f8f6f4(k00, q8[0], ci, 0, 0, 0, SC8, 0, SC8Q);
  p1 = __builtin_amdgcn_mfma_scale_f32_32x32x64_f8f6f4(k10, q8[0], ci, 0, 0, 0, SC8, 0, SC8Q);
  p0 = __builtin_amdgcn_mfma_scale_f32_32x32x64_f8f6f4(cat8x(Kt, ka1), q8[1], p0, 0, 0, 0, SC8, 0, SC8Q);
  p1 = __builtin_amdgcn_mfma_scale_f32_32x32x64_f8f6f4(cat8x(Kt + 4096, ka1), q8[1], p1, 0, 0, 0, SC8, 0, SC8Q);
}
__device__ __forceinline__ void pv8(f32x16* o, const char* Vt, const v8i& P8, int va, f32x16& ls, const v8i& ones) {
#pragma unroll
  for (int db = 0; db < 4; ++db) o[db] = __builtin_amdgcn_mfma_scale_f32_32x32x64_f8f6f4(cat8x(Vt + db * 2048, va), P8, o[db], 0, 0, 0, SC8, 0, SC8);
  ls = __builtin_amdgcn_mfma_scale_f32_32x32x64_f8f6f4(ones, P8, ls, 0, 0, 0, 127 * 0x01010101, 0, 127 * 0x01010101);
}
template <int MODE>
__device__ __forceinline__ void attn_a8(const unsigned char* __restrict__ Q8, const unsigned char* __restrict__ K8, const unsigned char* __restrict__ VT, unsigned char* __restrict__ Ob, int NT, char* lds, int qrel, float sl, float sink_raw) {
  const int tid = tid_fresh(), wid = tid >> 6, lane = tid & 63, r32 = lane & 31, hi = lane >> 5;
  char* K_lds = lds; char* V_lds = lds + 4 * TB;
  const float m_reg = MODE ? sink_raw : 0.f; f32x16 o[4] = {}; v8i q8[2];
  f32x16 ls; v8i ones;
  { float l0 = MODE ? (float)(1 << L_QK) : 0.f; int one4 = 0x38383838; asm volatile("" : "+v"(l0), "+v"(one4));
#pragma unroll
    for (int r = 0; r < 16; ++r) ls[r] = l0;
#pragma unroll
    for (int r = 0; r < 8; ++r) ones[r] = one4; }
  f32x16 ci;
  { float c0 = (float)L_QK - m_reg; asm volatile("" : "+v"(c0));
#pragma unroll
    for (int r = 0; r < 16; ++r) ci[r] = c0; }
  const int dq0 = qrel + wid * 32 + r32 - 4 * hi;
#define WB8(P0, P1, j) do { if (MODE) att::win_bias(P0, P1, dq0 - (j) * 64, sl); } while (0)
  { const unsigned char* qp = Q8 + (long)(wid * 32 + r32) * 2048 + 32 * hi; q8[0] = CAT8(qp); q8[1] = CAT8(qp + 64); }
  const int swk = (r32 >> 1) & 7, swv = (r32 >> 2) & 3;
  const int ka0 = r32 * 128 + (((0 + 2 * hi) ^ swk) << 4), ka1 = r32 * 128 + (((4 + 2 * hi) ^ swk) << 4);
  const int va = r32 * 64 + (((2 * hi) ^ swv) << 4);
  const int kr = tid >> 3, vd = tid >> 2; const bool late = wid >= 4;
  const unsigned goK = (unsigned)(kr * 512 + (((tid & 7) ^ ((kr >> 1) & 7)) << 4)), goV = (unsigned)(vd * 64 + (((tid & 3) ^ ((vd >> 2) & 3)) << 4));
  LAS char* const Lw = (LAS char*)lds + __builtin_amdgcn_readfirstlane(wid) * 1024;
#define DMAK8(j, rb) __builtin_amdgcn_global_load_lds((const unsigned*)((const char*)K8 + (size_t)(j) * (64 * 512) + goK), (LAS unsigned*)(Lw + (rb)), 16, 0, 0)
#define DMAV8(j, rb) __builtin_amdgcn_global_load_lds((const unsigned*)((const char*)VT + (size_t)(j) * (4 * TB) + goV), (LAS unsigned*)(Lw + 4 * TB + (rb)), 16, 0, 0)
#define WAITV8(n) asm volatile("s_waitcnt vmcnt(" #n ") lgkmcnt(0)" ::: "memory")
#define BAR8() do { __builtin_amdgcn_s_barrier(); asm volatile("" ::: "memory"); } while (0)
  f32x16 p0, p1; v8i P8 = {}, kf0, kf1;
#define KPRE8(KR) do { kf0 = cat8x(K_lds + (KR), ka0); kf1 = cat8x(K_lds + (KR) + 4096, ka0); } while (0)
  __syncthreads();
  DMAK8(0, 0); DMAV8(0, 0); DMAK8(1, TB); DMAK8(2, 2 * TB); WAITV8(0); BAR8();
  if (late) BAR8();
  __builtin_amdgcn_s_setprio(1);
  KPRE8(0);
  qkt8(p0, p1, K_lds, q8, ka0, ka1, ci, kf0, kf1); __builtin_amdgcn_sched_barrier(0);
  DMAK8(3 < NT ? 3 : NT - 1, 3 < NT ? 3 * TB : 8 * TB); DMAV8(1, TB);
  WAITV8(2);
  __builtin_amdgcn_s_setprio(0); BAR8();
  WB8(p0, p1, 0); softmax8<MODE == 0>(p0, p1, ci, ls, o, P8); KPRE8(TB); BAR8();
#define STEP8(t, KR, VR, KN) do { const int t_ = (t); const bool sk = t_ + 3 < NT, sv = t_ + 1 < NT; \
    __builtin_amdgcn_s_setprio(1); \
    qkt8(p0, p1, K_lds + (KR), q8, ka0, ka1, ci, kf0, kf1); __builtin_amdgcn_sched_barrier(0); \
    DMAK8(sk ? t_ + 3 : NT - 1, sk ? (VR) : 8 * TB); DMAV8(sv ? t_ + 1 : NT - 1, sv ? (KN) : 5 * TB);     \
    __builtin_amdgcn_sched_barrier(0); pv8(o, V_lds + (VR), P8, va, ls, ones); \
    WAITV8(2); \
    __builtin_amdgcn_s_setprio(0); BAR8(); \
    WB8(p0, p1, t_); softmax8<false>(p0, p1, ci, ls, o, P8); KPRE8(KN); BAR8(); } while (0)
  int t = 1;
  for (; t + 3 < NT; t += 4) { STEP8(t, TB, 0, 2 * TB); STEP8(t + 1, 2 * TB, TB, 3 * TB); STEP8(t + 2, 3 * TB, 2 * TB, 0); STEP8(t + 3, 0, 3 * TB, TB); }
  const int rem = NT - t;
  if (rem >= 1) STEP8(t, TB, 0, 2 * TB);
  if (rem >= 2) STEP8(t + 1, 2 * TB, TB, 3 * TB);
  if (rem >= 3) STEP8(t + 2, 3 * TB, 2 * TB, 0);
  if (rem == 0) pv8(o, V_lds, P8, va, ls, ones); else if (rem == 1) pv8(o, V_lds + TB, P8, va, ls, ones); else if (rem == 2) pv8(o, V_lds + 2 * TB, P8, va, ls, ones); else pv8(o, V_lds + 3 * TB, P8, va, ls, ones);
  WAITV8(0); BAR8();
  if (!late) BAR8();
#undef STEP8
#undef KPRE8
#undef DMAK8
#undef DMAV8
#undef WAITV8
#undef BAR8
  { const float rl = __builtin_amdgcn_rcpf(ls[0]) * (float)(1 << (L_Y + L_QK));
    const int t2 = tid_fresh(); unsigned char* Ow = Ob + (unsigned)(((t2 >> 6) * 32 + (t2 & 31)) * DM + 4 * ((t2 >> 5) & 1));
#pragma unroll
    for (int d0 = 0; d0 < 4; ++d0)
#pragma unroll
      for (int g = 0; g < 4; ++g) *(unsigned*)(Ow + d0 * 32 + 8 * g) = pk4_fp8(o[d0][4 * g] * rl, o[d0][4 * g + 1] * rl, o[d0][4 * g + 2] * rl, o[d0][4 * g + 3] * rl); }
#undef WB8
}
#undef CAT8
}

#define XB_TMO      128
#define XB_XCNT(j)  (256  + 64 * (j))
#define XB_XSUB(j)  (1280 + 64 * (j))
#define XB_XGEN(j)  (2304 + 64 * (j))
#define XB_TOP      3328
#define XB_TOPGEN   3392
#define XCD_BAR_WORDS 3456
#define XB_SPIN_CAP (1u << 18)
__device__ __forceinline__ unsigned xb_ld(unsigned* p)              { return __hip_atomic_load(p, __ATOMIC_RELAXED, __HIP_MEMORY_SCOPE_AGENT); }
__device__ __forceinline__ unsigned xb_add(unsigned* p, unsigned v) { return __hip_atomic_fetch_add(p, v, __ATOMIC_RELAXED, __HIP_MEMORY_SCOPE_AGENT); }
__device__ __forceinline__ unsigned xb_xcc_id() { return (unsigned)__builtin_amdgcn_s_getreg((3 << 11) | 20) & 0xFu; }
#define XB_SPIN(cond, bar) do { unsigned _sp = 0; while (cond) { __builtin_amdgcn_s_sleep(1); \
    if ((++_sp & 255u) == 0u) { if (xb_ld(&(bar)[XB_TMO])) break; if (_sp > XB_SPIN_CAP) { atomicAdd(&(bar)[XB_TMO], 1u); break; } } } } while (0)
struct XcdBarrier { unsigned* bar; unsigned x; volatile LAS unsigned* st; };
__device__ __forceinline__ XcdBarrier xcd_barrier_post(unsigned* bar, volatile LAS unsigned* st) {
    XcdBarrier b; b.bar = bar; b.x = xb_xcc_id(); b.st = st;
    if (threadIdx.x == 0) (void)xb_add(&bar[XB_XCNT(b.x)], 1u);
    return b;
}
__device__ __forceinline__ void xcd_barrier_complete(unsigned* bar, unsigned x, unsigned& nloc, unsigned& nx) {
    const unsigned G = gridDim.x * gridDim.y * gridDim.z;
    unsigned sum, cnt, mine, sp = 0u;
    for (;;) {
        sum = 0u; cnt = 0u; mine = 0u;
#pragma unroll
        for (unsigned j = 0; j < 16; ++j) { const unsigned c = xb_ld(&bar[XB_XCNT(j)]); sum += c; cnt += (c > 0u) ? 1u : 0u; mine = (j == x) ? c : mine; }
        if (sum == G) break;
        __builtin_amdgcn_s_sleep(1);
        if ((++sp & 255u) == 0u) { if (xb_ld(&bar[XB_TMO])) break; if (sp > XB_SPIN_CAP) { atomicAdd(&bar[XB_TMO], 1u); break; } }
    }
    nloc = mine > 0u ? mine : 1u; nx = cnt > 0u ? cnt : 1u;
}
__device__ __forceinline__ void xcd_barrier(const XcdBarrier& b) {
    asm volatile("s_waitcnt vmcnt(0)" ::: "memory");
    __syncthreads();
    if (threadIdx.x == 0) {
        unsigned* bar = b.bar;
        __builtin_amdgcn_s_waitcnt(0);
        unsigned nloc = b.st[0], nx = b.st[1];
        if (nloc == 0u) { xcd_barrier_complete(bar, b.x, nloc, nx); b.st[0] = nloc; b.st[1] = nx; }
        const unsigned old = xb_add(&bar[XB_XSUB(b.x)], 1u);
        const unsigned gen = old / nloc;
        if (old + 1u == (gen + 1u) * nloc) {
            __builtin_amdgcn_fence(__ATOMIC_RELEASE, "agent");
            asm volatile("s_waitcnt vmcnt(0)" ::: "memory");
            const unsigned og = xb_add(&bar[XB_TOP], 1u);
            const unsigned tg = og / nx;
            if (og + 1u == (tg + 1u) * nx) xb_add(&bar[XB_TOPGEN], 1u);
            else XB_SPIN(xb_ld(&bar[XB_TOPGEN]) == tg, bar);
            __builtin_amdgcn_fence(__ATOMIC_ACQUIRE, "agent");
            xb_add(&bar[XB_XGEN(b.x)], 1u);
            asm volatile("s_waitcnt vmcnt(0)" ::: "memory");
        } else {
            XB_SPIN(xb_ld(&bar[XB_XGEN(b.x)]) == gen, bar);
            __builtin_amdgcn_fence(__ATOMIC_ACQUIRE, "agent");
            asm volatile("s_waitcnt vmcnt(0)" ::: "memory");
        }
    }
    __syncthreads();
}

struct Args { const float* in[20]; float* out; unsigned char* ws; int ph_lo, ph_hi; };
struct Frame {
    LAS unsigned char* lds;
    int tid, lane, wave, vcu, G;
    const float *xp, *xs, *cp, *cs, *w_ada, *b_ada, *w_in, *qn, *kn, *sink, *wbra, *wbrb, *wo, *ln1g, *ln1b, *wg, *wu, *wd, *ln2g, *ln2b;
    float* out; float* mod; float* rope; float* rsc; float* csc; unsigned* cmax;
    bf16 *Win_t, *Wbr_t, *Wo_t, *Wgu_t, *Wd_t, *H, *Y, *P;
    unsigned char *QA8, *KA8, *VT8, *QB8, *KB8, *VTB8;
};
typedef const __attribute__((address_space(4))) Args* KArgs;
__device__ __forceinline__ void frame_ptrs(Frame& F) {
    unsigned long long kp = (unsigned long long)__builtin_amdgcn_kernarg_segment_ptr(); asm volatile("" : "+s"(kp));
    KArgs a = (KArgs)kp; unsigned char* ws = a->ws;
    F.tid = tid_fresh(); F.lane = F.tid & 63; F.wave = __builtin_amdgcn_readfirstlane(F.tid >> 6);
    F.xp = a->in[0]; F.xs = a->in[1]; F.cp = a->in[2]; F.cs = a->in[3]; F.w_ada = a->in[4]; F.b_ada = a->in[5]; F.w_in = a->in[6]; F.qn = a->in[7]; F.kn = a->in[8]; F.sink = a->in[9];
    F.wbra = a->in[10]; F.wbrb = a->in[11]; F.wo = a->in[12]; F.ln1g = a->in[13]; F.ln1b = a->in[14]; F.wg = a->in[15]; F.wu = a->in[16]; F.wd = a->in[17]; F.ln2g = a->in[18]; F.ln2b = a->in[19];
    F.out = a->out; F.mod = (float*)(ws + WS_MOD); F.rope = (float*)(ws + WS_ROPE); F.rsc = (float*)(ws + WS_RSC); F.csc = (float*)(ws + WS_CSC); F.cmax = (unsigned*)(ws + WS_CTL) + CW_CMAX;
    F.Win_t = (bf16*)(ws + WS_WIN); F.Wbr_t = (bf16*)(ws + WS_WBR); F.Wo_t = (bf16*)(ws + WS_WO); F.Wgu_t = (bf16*)(ws + WS_WGU); F.Wd_t = (bf16*)(ws + WS_WD);
    F.H = (bf16*)(ws + WS_H); F.Y = (bf16*)(ws + WS_Y); F.P = (bf16*)(ws + WS_P);
    F.QA8 = ws + WS_QA8; F.KA8 = ws + WS_KA8; F.VT8 = ws + WS_VT8; F.QB8 = ws + WS_QB8; F.KB8 = ws + WS_KB8; F.VTB8 = ws + WS_VTB8;
}
__device__ __forceinline__ float wave_sum(float v) {
#pragma unroll
    for (int o = 1; o < 64; o <<= 1) v += __shfl_xor(v, o);
    return v;
}
__device__ __forceinline__ void p0_transpose_tile(const float* W, int N, int k0, int n0, bf16* WT, int dst_row0, int dst_k0, int ldk, LAS float* scr, int lane) {
    { f32x4 t_[8]; const int c4 = 4 * (lane & 7);
#pragma unroll
      for (int i = 0; i < 8; ++i) t_[i] = __builtin_nontemporal_load((const f32x4*)(W + (size_t)(k0 + 8 * i + (lane >> 3)) * N + n0 + c4));
#pragma unroll
      for (int i = 0; i < 8; ++i) { LAS float* d_ = scr + (8 * i + (lane >> 3)) * 33 + c4; d_[0] = t_[i][0]; d_[1] = t_[i][1]; d_[2] = t_[i][2]; d_[3] = t_[i][3]; } }
    LDS_WAIT(); asm volatile("" ::: "memory");
    const int c = lane & 7;
#pragma unroll
    for (int j = 0; j < 4; ++j) { const int n = (lane >> 3) + 8 * j; const LAS float* s = scr + (8 * c) * 33 + n;
        v4u o; o.x = cvt_pk_bf16(s[0 * 33], s[1 * 33]); o.y = cvt_pk_bf16(s[2 * 33], s[3 * 33]); o.z = cvt_pk_bf16(s[4 * 33], s[5 * 33]); o.w = cvt_pk_bf16(s[6 * 33], s[7 * 33]);
        *(GAS v4u*)(WT + (size_t)(dst_row0 + n) * ldk + dst_k0 + 8 * c) = o; }
    LDS_WAIT(); asm volatile("" ::: "memory");
}
template <bool QKP>
__device__ __forceinline__ void p0_transpose_tile_f8(const float* W, int N, int k0, int n0, unsigned char* WT, int dst_row0, int dst_k0, int ldk, float sc, LAS float* scr, int lane) {
    { f32x4 t_[8]; const int c4 = 4 * (lane & 7);
#pragma unroll
      for (int i = 0; i < 8; ++i) t_[i] = __builtin_nontemporal_load((const f32x4*)(W + (size_t)(k0 + 8 * i + (lane >> 3)) * N + n0 + c4));
#pragma unroll
      for (int i = 0; i < 8; ++i) { LAS float* d_ = scr + (8 * i + (lane >> 3)) * 33 + c4; d_[0] = t_[i][0]; d_[1] = t_[i][1]; d_[2] = t_[i][2]; d_[3] = t_[i][3]; } }
    LDS_WAIT(); asm volatile("" ::: "memory");
    const int c = lane & 7;
#pragma unroll
    for (int j = 0; j < 4; ++j) { const int n = (lane >> 3) + 8 * j; const LAS float* s = scr + (8 * c) * 33 + n;
        v2u o; o.x = pk4_fp8(s[0 * 33] * sc, s[1 * 33] * sc, s[2 * 33] * sc, s[3 * 33] * sc); o.y = pk4_fp8(s[4 * 33] * sc, s[5 * 33] * sc, s[6 * 33] * sc, s[7 * 33] * sc);
        const int t_ = (n0 >> 5) & 3; const int row = QKP ? (n0 & ~127) + 64 * (t_ >> 1) + 32 * (n >> 4) + 8 * ((n >> 2) & 3) + 4 * (t_ & 1) + (n & 3) : dst_row0 + n;
        *(GAS v2u*)(WT + (size_t)row * ldk + dst_k0 + 8 * c) = o; }
    LDS_WAIT(); asm volatile("" ::: "memory");
}
__device__ __forceinline__ void p0_transpose_tile_i8(const float* W, int N, int k0, int n0, unsigned char* WT, int dst_row0, int dst_k0, int ldk, const unsigned* cm, LAS float* scr, int lane) {
    { f32x4 t_[8]; const int c4 = 4 * (lane & 7);
#pragma unroll
      for (int i = 0; i < 8; ++i) t_[i] = __builtin_nontemporal_load((const f32x4*)(W + (size_t)(k0 + 8 * i + (lane >> 3)) * N + n0 + c4));
#pragma unroll
      for (int i = 0; i < 8; ++i) { LAS float* d_ = scr + (8 * i + (lane >> 3)) * 33 + c4; d_[0] = t_[i][0]; d_[1] = t_[i][1]; d_[2] = t_[i][2]; d_[3] = t_[i][3]; } }
    LDS_WAIT(); asm volatile("" ::: "memory");
    const int c = lane & 7;
#pragma unroll
    for (int j = 0; j < 4; ++j) { const int n = (lane >> 3) + 8 * j; const LAS float* s = scr + (8 * c) * 33 + n;
        const float mx = __uint_as_float(cm[dst_row0 + n]); const float inv = mx > 0.f ? 127.0f / mx : 0.f; int q[8];
#pragma unroll
        for (int e = 0; e < 8; ++e) q[e] = (int)__builtin_rintf(s[e * 33] * inv) & 0xff;
        v2u o; o.x = (unsigned)(q[0] | (q[1] << 8) | (q[2] << 16) | (q[3] << 24)); o.y = (unsigned)(q[4] | (q[5] << 8) | (q[6] << 16) | (q[7] << 24));
        *(GAS v2u*)(WT + (size_t)(dst_row0 + n) * ldk + dst_k0 + 8 * c) = o; }
    LDS_WAIT(); asm volatile("" ::: "memory");
}
__device__ __forceinline__ void sincos_poly(double y, double& s, double& c) {
    const double y2 = y * y; double ts = y, tc = 1.0; s = y; c = 1.0;
#pragma unroll
    for (int n = 1; n <= 15; ++n) { tc *= -y2 * (1.0 / (double)((2 * n - 1) * (2 * n))); c += tc; ts *= -y2 * (1.0 / (double)((2 * n) * (2 * n + 1))); s += ts; }
}

__device__ __forceinline__ void phase0(Frame& F) {
    LAS float* sc = (LAS float*)F.lds;
    LAS float* part = (LAS float*)(F.lds + 81920);
    for (int i = F.tid; i < NBATCH * DM; i += NWAVES * 64) { const float c = i < DM ? F.cp[i] : F.cs[i - DM]; sc[i] = c * sigmoidf_(c); }
    __syncthreads();
    for (int cb = F.vcu; cb < (NMOD * DM) / 96; cb += F.G) {
        if (F.tid < 504) { const int ct = F.tid % 24, kg = F.tid / 24; const float* wp = F.w_ada + (size_t)cb * 96 + 4 * ct;
            f32x4 a0 = {0, 0, 0, 0}, a1 = a0, a2 = a0, a3 = a0, a4 = a0;
#pragma unroll 4
            for (int k = kg; k < DM; k += 21) { const f32x4 wv = *(const f32x4*)(wp + (size_t)k * (NMOD * DM));
                a0 += wv * sc[k]; a1 += wv * sc[DM + k]; a2 += wv * sc[2 * DM + k]; a3 += wv * sc[3 * DM + k]; a4 += wv * sc[4 * DM + k]; }
            LAS f32x4* pp = (LAS f32x4*)(part + (kg * 24 + ct) * 20); pp[0] = a0; pp[1] = a1; pp[2] = a2; pp[3] = a3; pp[4] = a4; }
        __syncthreads();
        if (F.tid < 480) { const int b = F.tid / 96, j = F.tid % 96, ct = j >> 2, e = j & 3; float s = F.b_ada[cb * 96 + j];
            for (int kg = 0; kg < 21; ++kg) s += part[(kg * 24 + ct) * 20 + b * 4 + e];
            F.mod[(size_t)b * NMOD * DM + cb * 96 + j] = s; }
        __syncthreads();
    }
    { const int gt = F.vcu * NWAVES * 64 + F.tid;
      if (gt < 6144) { const int isc = gt >= 4096, idx = isc ? gt - 4096 : gt, pos = idx >> 5, i = idx & 31;
          double inv = 1.0; for (int k = 0; k < i; ++k) inv *= 0.7498942093324559;
          const double ang = (double)pos * inv; const double kq = __builtin_rint(ang * 0.15915494309189535); const double y = ang - kq * 6.283185307179586;
          double s, c; sincos_poly(y, s, c);
          float* cosp = F.rope + (isc ? 8192 : 0); float* sinp = cosp + (isc ? 2048 : 4096);
          cosp[idx] = (float)c; sinp[idx] = (float)s; } }
    LAS float* scr = (LAS float*)(F.lds + F.wave * 16384);
    const int gw = F.vcu * NWAVES + F.wave, NGW = F.G * NWAVES;
    constexpr int I_IN = (DM / 64) * (IN_W / 32);
    for (int it = gw; it < I_IN; it += NGW) { const int nb = IN_W / 32, kb = it / nb, n0 = 32 * (it % nb);
        if (n0 < C_VA) p0_transpose_tile_f8<true>(F.w_in, IN_W, 64 * kb, n0, (unsigned char*)F.Win_t, n0, 64 * kb, DM, (float)(1 << L_WIN), scr, F.lane);
        else p0_transpose_tile_f8<false>(F.w_in, IN_W, 64 * kb, n0, (unsigned char*)F.Win_t, n0, 64 * kb, DM, (float)(1 << L_WIN), scr, F.lane); }
}
__device__ __forceinline__ void side2(Frame& F) {
    LAS float* scr = (LAS float*)(F.lds + F.wave * 16384);
    const int gw = F.vcu * NWAVES + F.wave, NGW = F.G * NWAVES;
    constexpr int I_BR = (2048 / 64) * (DM / 32), I_O = (DM / 64) * (DM / 32), I_D = (DFF / 64) * (DM / 32);
    constexpr int NITEMS = 2 * I_BR + I_O + I_D;
    for (int it = gw; it < NITEMS; it += NGW) {
        int r = it;
        if (r < I_BR) { const int nb = DM / 32, kb = r / nb, n0 = 32 * (r % nb); p0_transpose_tile_f8<false>(F.wbra, DM, 64 * kb, n0, (unsigned char*)F.Wbr_t, n0, 64 * kb, DM, (float)(1 << L_WBR), scr, F.lane); continue; } r -= I_BR;
        if (r < I_BR) { const int nb = DM / 32, kb = r / nb, n0 = 32 * (r % nb); p0_transpose_tile_f8<false>(F.wbrb, DM, 64 * kb, n0, (unsigned char*)F.Wbr_t, n0, 2048 + 64 * kb, DM, (float)(1 << L_WBR), scr, F.lane); continue; } r -= I_BR;
        if (r < I_O) { const int nb = DM / 32, kb = r / nb, n0 = 32 * (r % nb); p0_transpose_tile_f8<false>(F.wo, DM, 64 * kb, n0, (unsigned char*)F.Wo_t, n0, 64 * kb, DM, (float)(1 << L_WO), scr, F.lane); continue; } r -= I_O;
        { const int nb = DM / 32, kb = r / nb, n0 = 32 * (r % nb); p0_transpose_tile(F.wd, DM, 64 * kb, n0, F.Wd_t, n0, 64 * kb, DFF, scr, F.lane); }
    }
    for (int it = gw; it < 2 * 16 * 43; it += NGW) { const int mat = it / (16 * 43), r = it % (16 * 43), ks = r / 43, cb = r % 43; const int c = cb * 256 + 4 * F.lane;
        const float* wp = (mat ? F.wu : F.wg) + (size_t)(ks * 256) * DFF + c; f32x4 mx = {0.f, 0.f, 0.f, 0.f};
#pragma unroll 8
        for (int k = 0; k < 256; ++k) { const f32x4 wv = __builtin_nontemporal_load((const f32x4*)(wp + (size_t)k * DFF)); mx = __builtin_elementwise_max(mx, __builtin_elementwise_abs(wv)); }
        unsigned* cm = F.cmax + 256 * (c >> 7) + (mat ? 128 : 0) + (c & 127);
#pragma unroll
        for (int e = 0; e < 4; ++e) atomicMax(cm + e, __float_as_uint(mx[e])); }
}
__device__ __forceinline__ void side4(Frame& F) {
    LAS float* scr = (LAS float*)(F.lds + F.wave * 16384);
    const int gw = F.vcu * NWAVES + F.wave, NGW = F.G * NWAVES;
    constexpr int I_G = (DM / 64) * (DFF / 32);
    for (int it = gw; it < 2 * I_G; it += NGW) { const int mat = it >= I_G, r = mat ? it - I_G : it; const int nb = DFF / 32, kb = r / nb, n0 = 32 * (r % nb);
        p0_transpose_tile_i8(mat ? F.wu : F.wg, DFF, 64 * kb, n0, (unsigned char*)F.Wgu_t, 256 * (n0 >> 7) + (mat ? 128 : 0) + (n0 & 127), 64 * kb, DM, F.cmax, scr, F.lane); }
    for (int i = F.vcu * NWAVES * 64 + F.tid; i < 2 * DFF; i += F.G * NWAVES * 64) F.csc[i] = __uint_as_float(F.cmax[i]) * (1.0f / 127.0f);
}
__device__ __forceinline__ void row_stats(const f32x4 (&v)[16], float& mean, float& rstd) {
    float s = 0.f;
#pragma unroll
    for (int j = 0; j < 16; ++j) s += (v[j].x + v[j].y) + (v[j].z + v[j].w);
    mean = wave_sum(s) * (1.f / DM); float s2 = 0.f;
#pragma unroll
    for (int j = 0; j < 16; ++j) { const f32x4 d = v[j] - mean; s2 += (d.x * d.x + d.y * d.y) + (d.z * d.z + d.w * d.w); }
    rstd = 1.f / sqrtf(wave_sum(s2) * (1.f / DM) + LN_EPS);
}
__device__ __forceinline__ int row_batch(int m) { return m < SEQ_P ? 0 : 1 + ((m - SEQ_P) >> 12); }
__device__ __forceinline__ f32x4 ldg4(const float* base, unsigned off) { return *(const GAS f32x4*)((const GAS char*)base + off); }
__device__ __forceinline__ void stg4(float* base, unsigned off, f32x4 v) { *(GAS f32x4*)((GAS char*)base + off) = v; }
__device__ __forceinline__ void stg1(void* base, unsigned off, unsigned v) { *(GAS unsigned*)((GAS char*)base + off) = v; }
__device__ __forceinline__ void phase1(Frame& F) {
    const int gw = F.vcu * NWAVES + F.wave, NGW = F.G * NWAVES; const unsigned lo = (unsigned)F.lane * 16u;
    for (int m = gw; m < M; m += NGW) {
        const float* xrow = m < SEQ_P ? F.xp + (size_t)m * DM : F.xs + (size_t)(m - SEQ_P) * DM;
        const float* md = F.mod + (size_t)row_batch(m) * NMOD * DM;
        f32x4 v[16];
#pragma unroll
        for (int j = 0; j < 16; ++j) v[j] = ldg4(xrow, lo + 1024u * j);
        float mean, rstd; row_stats(v, mean, rstd);
        unsigned char* orow = (unsigned char*)F.H + (size_t)m * DM; constexpr float SC = (float)(1 << L_H1);
#pragma unroll
        for (int j = 0; j < 16; ++j) { const f32x4 sh = ldg4(md, lo + 1024u * j), scl = ldg4(md + DM, lo + 1024u * j);
            const f32x4 y = ((v[j] - mean) * rstd * (scl + 1.0f) + sh) * SC; stg1(orow, (unsigned)F.lane * 4u + 256u * j, pk4_fp8(y.x, y.y, y.z, y.w)); }
    }
}
__device__ __forceinline__ void phase4(Frame& F, char* lds) {
    for (int idx = F.vcu; idx < 1536; idx += F.G) {
        const bool pr = idx < 512; const int u = pr ? idx : idx - 512;
        const int head = pr ? u >> 5 : (u >> 4) & 15, qb = pr ? u & 31 : u & 15; const size_t row0 = pr ? 0 : SEQ_P + (size_t)(u >> 8) * SEQ_S;
        att8::attn_a8<0>(F.QA8 + (row0 + qb * 256) * 2048 + head * HD, F.KA8 + row0 * 512 + (head >> 2) * HD, F.VT8 + ((row0 >> 6) * 4 + (head >> 2)) * (size_t)att8::TB,
            (unsigned char*)F.Y + (row0 + qb * 256) * DM + head * HD, pr ? SEQ_P / 64 : SEQ_S / 64, lds, 0, 0.f, 0.f); }
    for (int u = F.vcu; u < 1536; u += F.G) { const int pm = u >> 4, head = u & 15;
        const int T = pm < 32 ? SEQ_P : SEQ_S, qb = pm < 32 ? pm : (pm - 32) & 15; const size_t row0 = pm < 32 ? 0 : SEQ_P + (size_t)((pm - 32) >> 4) * SEQ_S;
        const int q0 = qb * 256, ks = q0 >= 128 ? q0 - 128 : 0, ke = q0 + 384 <= T ? q0 + 384 : T;
        const float slope = __builtin_amdgcn_exp2f(-0.5f * (float)(head + 1));
        const size_t kr0 = row0 + ks; att8::attn_a8<1>(F.QB8 + (row0 + q0) * 2048 + head * HD, F.KB8 + kr0 * 512 + (head >> 2) * HD, F.VTB8 + ((kr0 >> 6) * 4 + (head >> 2)) * (size_t)att8::TB,
            (unsigned char*)F.Y + (row0 + q0) * DM + 2048 + head * HD, (ke - ks) / 64, lds, q0 - ks, slope * 1.4426950408889634f, F.sink[head] * 1.4426950408889634f); }
}
__device__ __forceinline__ void ld_row_h(const unsigned short* row, unsigned lane, f32x4 (&v)[16]) {
#pragma unroll
    for (int j = 0; j < 8; ++j) { const v4u hv = *(const GAS v4u*)((const GAS char*)row + lane * 16u + 1024u * j);
        v[2 * j] = (f32x4){h_lo(hv.x), h_hi(hv.x), h_lo(hv.y), h_hi(hv.y)}; v[2 * j + 1] = (f32x4){h_lo(hv.z), h_hi(hv.z), h_lo(hv.w), h_hi(hv.w)}; }
}
__device__ __forceinline__ void phase7(Frame& F) {
    const int gw = F.vcu * NWAVES + F.wave, NGW = F.G * NWAVES; const unsigned ln = (unsigned)F.lane, lo = ln * 32u;
    for (int m = gw; m < M; m += NGW) {
        const float* md = F.mod + (size_t)row_batch(m) * NMOD * DM;
        f32x4 v[16]; ld_row_h((const unsigned short*)F.P + (size_t)m * DM, ln, v);
        float mean, rstd; row_stats(v, mean, rstd);
        unsigned short* xrow = (unsigned short*)F.H + (size_t)m * DM;
#pragma unroll
        for (int j = 0; j < 8; ++j) {
#pragma unroll
            for (int h = 0; h < 2; ++h) { const f32x4 g = ldg4(F.ln1g, lo + 2048u * j + 16u * h), b = ldg4(F.ln1b, lo + 2048u * j + 16u * h); v[2 * j + h] = (v[2 * j + h] - mean) * rstd * g + b; }
            v4u w; w.x = pk_h2(v[2 * j].x, v[2 * j].y); w.y = pk_h2(v[2 * j].z, v[2 * j].w); w.z = pk_h2(v[2 * j + 1].x, v[2 * j + 1].y); w.w = pk_h2(v[2 * j + 1].z, v[2 * j + 1].w);
            *(GAS v4u*)((GAS char*)xrow + ln * 16u + 1024u * j) = w;
            v[2 * j] = (f32x4){h_lo(w.x), h_hi(w.x), h_lo(w.y), h_hi(w.y)}; v[2 * j + 1] = (f32x4){h_lo(w.z), h_hi(w.z), h_lo(w.w), h_hi(w.w)}; }
        row_stats(v, mean, rstd);
        float amax = 0.f;
#pragma unroll
        for (int j = 0; j < 16; ++j) { const f32x4 sh = ldg4(md + 3 * DM, lo + 2048u * (j >> 1) + 16u * (j & 1)), scl = ldg4(md + 4 * DM, lo + 2048u * (j >> 1) + 16u * (j & 1));
            v[j] = (v[j] - mean) * rstd * (scl + 1.0f) + sh; amax = fmaxf(amax, fmaxf(fmaxf(fabsf(v[j].x), fabsf(v[j].y)), fmaxf(fabsf(v[j].z), fabsf(v[j].w)))); }
#pragma unroll
        for (int o = 1; o < 64; o <<= 1) amax = fmaxf(amax, __shfl_xor(amax, o));
        const float inv = amax > 0.f ? 127.0f / amax : 0.f;
        if (F.lane == 0) F.rsc[m] = amax * (1.0f / 127.0f);
        unsigned char* orow = (unsigned char*)F.Y + (size_t)m * DM;
#pragma unroll
        for (int j = 0; j < 8; ++j) { unsigned q[2];
#pragma unroll
            for (int h = 0; h < 2; ++h) { const f32x4 y = v[2 * j + h]; const int q0 = (int)__builtin_rintf(y.x * inv) & 0xff, q1 = (int)__builtin_rintf(y.y * inv) & 0xff, q2 = (int)__builtin_rintf(y.z * inv) & 0xff, q3 = (int)__builtin_rintf(y.w * inv) & 0xff;
                q[h] = (unsigned)(q0 | (q1 << 8) | (q2 << 16) | (q3 << 24)); }
            *(GAS v2u*)((GAS char*)orow + ln * 8u + 512u * j) = (v2u){q[0], q[1]}; }
    }
}
__device__ __forceinline__ void phase10(Frame& F) {
    const int gw = F.vcu * NWAVES + F.wave, NGW = F.G * NWAVES; const unsigned ln = (unsigned)F.lane, lo = ln * 32u;
    for (int m = gw; m < M; m += NGW) {
        f32x4 v[16]; ld_row_h((const unsigned short*)F.H + (size_t)m * DM, ln, v);
        float mean, rstd; row_stats(v, mean, rstd);
        float* orow = F.out + (size_t)m * DM;
#pragma unroll
        for (int j = 0; j < 16; ++j) { const unsigned off = lo + 2048u * (j >> 1) + 16u * (j & 1); const f32x4 g = ldg4(F.ln2g, off), b = ldg4(F.ln2b, off); stg4(orow, off, (v[j] - mean) * rstd * g + b); }
    }
}

__global__ void __launch_bounds__(NWAVES * 64, 2) enc_fwd(Args args) {
    extern __shared__ __attribute__((aligned(16))) unsigned char lds[];
    Frame F;
    F.lds = (LAS unsigned char*)lds;
    F.tid = threadIdx.x; F.lane = F.tid & 63; F.wave = __builtin_amdgcn_readfirstlane(F.tid >> 6);
    F.G = gridDim.x; { const int bx = blockIdx.x; F.vcu = (F.G % 8 == 0) ? (bx % 8) * (F.G / 8) + bx / 8 : bx; }
    gu32* ctl = (gu32*)(args.ws + WS_CTL);
    volatile LAS unsigned* MISC = (volatile LAS unsigned*)(F.lds + MISC_OFF);
    for (int u = F.tid; u < (LDS_BYTES - LDSCTL_OFF) / 4; u += NWAVES * 64) ((LAS unsigned*)(F.lds + LDSCTL_OFF))[u] = 0u;
    __syncthreads();
    XcdBarrier bar; bar.bar = (unsigned*)(ctl + CW_BAR); bar.x = 0; bar.st = nullptr;
    if (N_LAUNCHES == 1) bar = xcd_barrier_post((unsigned*)(ctl + CW_BAR), MISC + 8);
    const int lo = args.ph_lo, hi = args.ph_hi;
#ifndef PH_MASK
#define PH_MASK 0x7ff
#endif
#define IN(k) (((PH_MASK >> (k)) & 1) && lo <= (k) && (k) < hi)
#define SEAM(k) do { if (IN(k) && IN((k) + 1)) xcd_barrier(bar); } while (0)
#ifndef REP_PHASE
#define REP_PHASE -1
#endif
#define REPS(k) ((k) == REP_PHASE ? 2 : 1)
    if (IN(0)) for (int rep = 0; rep < REPS(0); ++rep) { if (rep) xcd_barrier(bar); frame_ptrs(F); phase0(F); } SEAM(0);
    if (IN(1)) for (int rep = 0; rep < REPS(1); ++rep) { if (rep) xcd_barrier(bar); frame_ptrs(F); phase1(F); } SEAM(1);
    if (IN(2)) for (int rep = 0; rep < REPS(2); ++rep) { if (rep) xcd_barrier(bar); frame_ptrs(F); if ((F.vcu & 1) == 0) { side2(F); __syncthreads(); frame_ptrs(F); } pg8::Gemm g{F.H, F.Win_t, DM, DM, DM, 0, e8m0x4(L_H1), e8m0x4(L_WIN)}; pg8::EpiProj E{F.P, F.qn, F.kn, F.rope, (LAS float*)(F.lds + LDSCTL_OFF + 1024), F.QA8, F.KA8, F.VT8, F.QB8, F.KB8, F.VTB8};
#if defined(KDOUBLE_PHASE) && KDOUBLE_PHASE == 2
        pg8::PairedOrder S; S.init(M, IN_W, F.G, (int)blockIdx.x); pg8::EpiHalf<pg8::EpiProj, false> E2{E}; pg8::gemm_phase<pg8::EpiHalf<pg8::EpiProj, false>, pg8::PairedOrder, 1>(F.lds, g, S, E2); }
#else
        pg8::StaticOrder S; S.init(M, IN_W, F.G, (int)blockIdx.x); pg8::gemm_phase<pg8::EpiProj, pg8::StaticOrder, 1>(F.lds, g, S, E); }
#endif
        if (IN(2) && (F.vcu & 1)) { frame_ptrs(F); side2(F); }
        SEAM(2);
    if (IN(4)) for (int rep = 0; rep < REPS(4); ++rep) { if (rep) xcd_barrier(bar); frame_ptrs(F); if ((F.vcu & 1) == 0) { side4(F); __syncthreads(); frame_ptrs(F); } phase4(F, (char*)lds); __syncthreads(); if (F.vcu & 1) { frame_ptrs(F); side4(F); } } SEAM(4);
    if (IN(5)) for (int rep = 0; rep < REPS(5); ++rep) { if (rep) xcd_barrier(bar); frame_ptrs(F); pg8::Gemm g{F.Y, F.Wbr_t, DM, DM, 2048, 2048, e8m0x4(L_Y), e8m0x4(L_WBR)}; pg8::PairedOrder S; S.init(M, DM, F.G, (int)blockIdx.x); pg8::EpiMerge E{F.P, (unsigned char*)F.H};
        pg8::gemm_phase<pg8::EpiMerge, pg8::PairedOrder, 1>(F.lds, g, S, E); } SEAM(5);
    if (IN(6)) for (int rep = 0; rep < REPS(6); ++rep) { if (rep) xcd_barrier(bar); frame_ptrs(F); pg8::Gemm g{F.H, F.Wo_t, DM, DM, DM, 0, e8m0x4(L_MG), e8m0x4(L_WO)}; pg8::StaticOrder S; S.init(M, DM, F.G, (int)blockIdx.x); pg8::EpiRes<false> E{F.xp, F.xs, nullptr, (unsigned short*)F.P, F.mod + 2 * DM};
        pg8::gemm_phase<pg8::EpiRes<false>, pg8::StaticOrder, 1>(F.lds, g, S, E); } SEAM(6);
    if (IN(7)) { frame_ptrs(F); phase7(F); } SEAM(7);
    if (IN(8)) for (int rep = 0; rep < REPS(8); ++rep) { if (rep) xcd_barrier(bar); frame_ptrs(F); pg8::Gemm g{F.Y, F.Wgu_t, DM, DM, DM, 0, 0, 0}; pg8::EpiSwiglu E{F.P, F.rsc, F.csc};
#if defined(KDOUBLE_PHASE) && KDOUBLE_PHASE == 8
        pg8::PairedOrder S; S.init(M, 2 * DFF, F.G, (int)blockIdx.x); pg8::EpiHalf<pg8::EpiSwiglu, true> E2{E}; pg8::gemm_phase<pg8::EpiHalf<pg8::EpiSwiglu, true>, pg8::PairedOrder, 2>(F.lds, g, S, E2); }
#else
        pg8::StaticOrder S; S.init(M, 2 * DFF, F.G, (int)blockIdx.x); pg8::gemm_phase<pg8::EpiSwiglu, pg8::StaticOrder, 2>(F.lds, g, S, E); }
#endif
        SEAM(8);
    if (IN(9)) { frame_ptrs(F); pg8::Gemm g{F.P, F.Wd_t, 2 * DFF, 2 * DFF, 2 * DFF, 0, 0, 0}; pg8::StaticOrder S; S.init(M, DM, F.G, (int)blockIdx.x, 2); pg8::EpiRes<true> E{nullptr, nullptr, (const unsigned short*)F.H, (unsigned short*)F.H, F.mod + 5 * DM};
        pg8::gemm_phase<pg8::EpiRes<true>, pg8::StaticOrder, 0>(F.lds, g, S, E); } SEAM(9);
    if (IN(10)) { frame_ptrs(F); phase10(F); }
#undef IN
#undef SEAM
}

extern "C" void kernel_launch(void* const* d_in, const int* in_sizes, int n_in, void* d_out, int out_size, void* d_ws, size_t ws_size, hipStream_t stream) {
    static int grid = 0;
    if (grid == 0) {
        if (n_in != 20 || in_sizes[0] != SEQ_P * DM || out_size != M * DM || ws_size < WS_END) {
            fprintf(stderr, "kernel_launch: shape mismatch: n_in %d in0 %d out %d ws %zu (need %zu)\n", n_in, n_in > 0 ? in_sizes[0] : -1, out_size, ws_size, (size_t)WS_END); grid = -1; return; }
        int dev = 0, cus = 0, per_cu = 0;
        if (hipGetDevice(&dev) != hipSuccess || hipDeviceGetAttribute(&cus, hipDeviceAttributeMultiprocessorCount, dev) != hipSuccess) { grid = -1; return; }
        if (hipFuncSetAttribute((const void*)enc_fwd, hipFuncAttributeMaxDynamicSharedMemorySize, LDS_BYTES) != hipSuccess) { fprintf(stderr, "kernel_launch: hipFuncSetAttribute failed\n"); grid = -1; return; }
        if (hipOccupancyMaxActiveBlocksPerMultiprocessor(&per_cu, (const void*)enc_fwd, NWAVES * 64, LDS_BYTES) != hipSuccess || per_cu < 1) { fprintf(stderr, "kernel_launch: occupancy query says %d\n", per_cu); (void)hipGetLastError(); grid = -1; return; }
        grid = cus;
    }
    if (grid < 0) return;
    (void)hipMemsetAsync((char*)d_ws + WS_CTL, 0, CTL_ZERO_BYTES, stream);
    Args a{};
    for (int i = 0; i < 20; ++i) a.in[i] = (const float*)d_in[i];
    a.out = (float*)d_out; a.ws = (unsigned char*)d_ws;
    if (N_LAUNCHES == 1) { a.ph_lo = 0; a.ph_hi = N_PHASES; hipLaunchKernelGGL(enc_fwd, dim3(grid), dim3(NWAVES * 64), LDS_BYTES, stream, a); }
    else for (int li = 0; li < N_PHASES; ++li) { a.ph_lo = li; a.ph_hi = li + 1; hipLaunchKernelGGL(enc_fwd, dim3(grid), dim3(NWAVES * 64), LDS_BYTES, stream, a); }
    const hipError_t le = hipPeekAtLastError();
    if (le != hipSuccess) fprintf(stderr, "kernel_launch: launch failed: %s\n", hipGetErrorName(le));
}
```

```cpp
#include <hip/hip_runtime.h>
#include <hip/hip_bf16.h>
#include <cstdio>
#include <cstdint>

#ifndef MK_N_LAUNCHES
#define MK_N_LAUNCHES 1
#endif
constexpr int N_PHASES = 11;
constexpr int N_LAUNCHES = MK_N_LAUNCHES;
constexpr int NWAVES = 8;

constexpr int DM = 4096, SEQ_P = 8192, SEQ_S = 4096, NB_S = 4, NBATCH = 5;
constexpr int M = SEQ_P + NB_S * SEQ_S;
constexpr int HD = 128, NHA = 16, NKVA = 4, NHB = 16, NKVB = 4;
constexpr int C_QA = 0, C_KA = 2048, C_VA = 2560, C_QB = 3072, C_KB = 5120, C_VB = 5632, C_GA = 6144, C_GB = 10240, IN_W = 14336;
constexpr int DFF = 11008, NMOD = 6;
constexpr int GATE_B0 = C_GA * 2;
constexpr float ALPHA = 1.189207115002721f, LN_EPS = 1e-5f, RMS_EPS = 1e-6f;
constexpr float ATT_SCALE = 0.088388347648318440f;
constexpr int L_H1 = 3, L_WIN = 9, L_Y = 5, L_WBR = 9, L_MG = 6, L_WO = 10, L_QK = 4;
constexpr float Q_PRE = ATT_SCALE * 1.4426950408889634f * 8.f;
constexpr int e8m0x4(int L) { return (127 - L) * 0x01010101; }

constexpr size_t MiB = 1u << 20;
constexpr size_t WS_CTL = 0, CTL_ZERO_BYTES = 1 * MiB;
constexpr size_t WS_MOD = 1 * MiB;
constexpr size_t WS_ROPE = 1 * MiB + 512 * 1024;
constexpr size_t WS_RSC = 1 * MiB + 640 * 1024;
constexpr size_t WS_CSC = 1 * MiB + 768 * 1024;
constexpr int CW_CMAX = 16384;
constexpr size_t WS_WIN = 2 * MiB;
constexpr size_t WS_WBR = WS_WIN + 112 * MiB;
constexpr size_t WS_WO = WS_WBR + 32 * MiB;
constexpr size_t WS_WGU = WS_WO + 32 * MiB;
constexpr size_t WS_WD = WS_WGU + 172 * MiB;
constexpr size_t WS_H = WS_WD + 86 * MiB;
constexpr size_t WS_Y = WS_H + 192 * MiB;
constexpr size_t WS_P = WS_Y + 96 * MiB;
constexpr size_t WS_QA8 = WS_P + 672 * MiB;
constexpr size_t WS_KA8 = WS_QA8 + 48 * MiB;
constexpr size_t WS_VT8 = WS_KA8 + 12 * MiB;
constexpr size_t WS_QB8 = WS_VT8 + 12 * MiB, WS_KB8 = WS_QB8 + 48 * MiB, WS_VTB8 = WS_KB8 + 12 * MiB;
constexpr size_t WS_END = WS_VTB8 + 12 * MiB;
static_assert((size_t)IN_W * DM * 2 <= 112 * MiB && (size_t)2 * DFF * DM * 2 <= 172 * MiB && (size_t)DM * DFF * 2 <= 86 * MiB && (size_t)M * IN_W * 2 <= 672 * MiB, "ws map");
constexpr int CW_TMO = 0, CW_BAR = 4096;

constexpr int RING_BYTES = 131072, LDSCTL_OFF = RING_BYTES, MISC_OFF = LDSCTL_OFF + 320, LDS_BYTES = 147456;

#define GAS __attribute__((address_space(1)))
#define LAS __attribute__((address_space(3)))
typedef unsigned short bf16;
typedef unsigned v4u __attribute__((ext_vector_type(4)));
typedef unsigned v2u __attribute__((ext_vector_type(2)));
typedef float f32x4 __attribute__((ext_vector_type(4)));
typedef float f32x2 __attribute__((ext_vector_type(2)));
typedef float f32x16 __attribute__((ext_vector_type(16)));
typedef short bf16x8 __attribute__((ext_vector_type(8)));
typedef short s16x4 __attribute__((ext_vector_type(4)));
typedef GAS unsigned gu32;
#define RLX_AGENT __ATOMIC_RELAXED, __HIP_MEMORY_SCOPE_AGENT
#define LDS_WAIT() asm volatile("s_waitcnt lgkmcnt(0)" ::: "memory")
#define VM_WAIT() asm volatile("s_waitcnt vmcnt(0)" ::: "memory")
__device__ __forceinline__ unsigned cvt_pk_bf16(float lo, float hi) { unsigned r; asm volatile("v_cvt_pk_bf16_f32 %0, %1, %2" : "=v"(r) : "v"(lo), "v"(hi)); return r; }
__device__ __forceinline__ float clamp448(float x) { return __builtin_amdgcn_fmed3f(x, -448.f, 448.f); }
__device__ __forceinline__ unsigned pk4_fp8(float a, float b, float c, float d) {
    int w = 0; w = __builtin_amdgcn_cvt_pk_fp8_f32(clamp448(a), clamp448(b), w, false); w = __builtin_amdgcn_cvt_pk_fp8_f32(clamp448(c), clamp448(d), w, true); return (unsigned)w; }
typedef _Float16 h16x2 __attribute__((ext_vector_type(2)));
__device__ __forceinline__ unsigned pk_h2(float a, float b) { const h16x2 h = {(_Float16)a, (_Float16)b}; return __builtin_bit_cast(unsigned, h); }
__device__ __forceinline__ float h_lo(unsigned w) { return (float)__builtin_bit_cast(h16x2, w)[0]; }
__device__ __forceinline__ float h_hi(unsigned w) { return (float)__builtin_bit_cast(h16x2, w)[1]; }
__device__ __forceinline__ unsigned pk4_gate(float a, float b, float c, float d) { unsigned w = 0;
    w = __builtin_amdgcn_cvt_pk_u8_f32(a * 256.f - 0.5f, 0, w); w = __builtin_amdgcn_cvt_pk_u8_f32(b * 256.f - 0.5f, 1, w); w = __builtin_amdgcn_cvt_pk_u8_f32(c * 256.f - 0.5f, 2, w); w = __builtin_amdgcn_cvt_pk_u8_f32(d * 256.f - 0.5f, 3, w); return w; }
template <int K> __device__ __forceinline__ float gate_f(unsigned w) { const float q = (float)((w >> (8 * K)) & 0xffu);
    return q * (1.f / 256.f) + (1.f / 512.f); }
__device__ __forceinline__ float bf_lo(unsigned w) { return __uint_as_float(w << 16); }
__device__ __forceinline__ float bf_hi(unsigned w) { return __uint_as_float(w & 0xffff0000u); }
__device__ __forceinline__ float sigmoidf_(float x) { return __builtin_amdgcn_rcpf(1.0f + __builtin_amdgcn_exp2f(-1.4426950408889634f * x)); }

__device__ __forceinline__ int kpos(int kappa) { const int k5 = kappa & 31; return 32 * ((k5 >> 2) & 1) + 16 * (kappa >> 5) + (k5 & 3) + 4 * (k5 >> 3); }
__device__ __forceinline__ int tid_fresh() { int t = threadIdx.x; asm volatile("" : "+v"(t)); return t; }

namespace pg8 {
constexpr int BM = 256, BK = 64, HALF = 128, HTB = HALF * BK * 2, STAGE_BYTES = 8 * HTB, NXCD = 8, WGM = 8;
__host__ __device__ __forceinline__ int lds_byte(int r, int c) { const int st = (r >> 4) * 2 + (c >> 5), rr = r & 15, cc = c & 31, ob = rr * 64 + cc * 2; return st * 1024 + (ob ^ (((ob >> 9) & 1) << 5)); }
__host__ __device__ __forceinline__ void stage_rc(int b, int& R, int& C) { const int st = b / 1024, sb = b % 1024, swz = sb ^ (((sb >> 9) & 1) << 5); R = (st >> 1) * 16 + swz / 64; C = (st & 1) * 32 + (swz % 64) / 2; }
__host__ __device__ __forceinline__ int perm32(int rho) { const int n = rho >> 4, i = rho & 15; return 8 * (i >> 2) + 4 * n + (i & 3); }

struct Unit { int pm, pn, kh; };
struct Gemm { const void* A; const void* Bt; int lda, ldb, kbytes, khoff; int sa, sb; };

struct StaticOrder {
    int nM, nN, nwg, G, c, wgm;
    __device__ void init(int M_, int N_, int G_, int c_, int wgm_ = WGM) { nM = M_ / BM; nN = N_ / BM; nwg = nM * nN; G = G_; c = c_; wgm = wgm_; }
    __device__ bool tile(int i, Unit& u) const {
        const long L = (long)i * G + c; if (L >= nwg) return false;
        int wgid = (int)L; { const int q = nwg / NXCD, r = nwg % NXCD, xcd = wgid % NXCD, off = wgid / NXCD; wgid = (xcd < r ? xcd * (q + 1) : r * (q + 1) + (xcd - r) * q) + off; }
        const int nig = wgm * nN, gid = wgid / nig, fm = gid * wgm, gsz = (nM - fm) < wgm ? (nM - fm) : wgm;
        u.pm = fm + ((wgid % nig) % gsz); u.pn = (wgid % nig) / gsz; u.kh = 0; return true;
    }
    __device__ bool next(int i, Unit& u) const { return tile(i, u); }
};
struct PairedOrder : StaticOrder {
    __device__ bool next(int i, Unit& u) const { const bool ok = tile(i >> 1, u); u.kh = i & 1; return ok; }
};

typedef f32x4 Acc[2][2][4][2];
typedef int v4i __attribute__((ext_vector_type(4)));
typedef int v8i __attribute__((ext_vector_type(8)));

struct EpiProj {
    static constexpr bool PERM = true, PAIRED = false;
    bf16* O; const float* qn; const float* kn; const float* rope; LAS float* xs;
    unsigned char* qa8; unsigned char* ka8; unsigned char* vt8; unsigned char* qb8; unsigned char* kb8; unsigned char* vtb8;
    __device__ __forceinline__ void operator()(const Acc& acc, const Unit& u, int wr, int wc, int fr, int fq) const {
        const int row0 = u.pm * BM + wr * 64 + fr;
        if (u.pn < 10) {
            const int p = wc >> 1, i0 = 16 * (wc & 1) + 4 * fq; const float* gn = (u.pn < 8 ? qn : kn) + 64 * p + i0;
            const f32x4 g1 = *(const f32x4*)gn, g2 = *(const f32x4*)(gn + 32);
#pragma unroll
            for (int ai = 0; ai < 2; ++ai)
#pragma unroll
                for (int m = 0; m < 4; ++m)
#pragma unroll
                    for (int bj = 0; bj < 2; ++bj) { const f32x4 v0 = acc[ai][bj][m][0], v1 = acc[ai][bj][m][1];
                        float ss = (v0[0] * v0[0] + v0[1] * v0[1]) + (v0[2] * v0[2] + v0[3] * v0[3]) + (v1[0] * v1[0] + v1[1] * v1[1]) + (v1[2] * v1[2] + v1[3] * v1[3]);
                        ss += __shfl_xor(ss, 16); ss += __shfl_xor(ss, 32);
                        if (fq == 0) xs[((ai * HALF + wr * 64 + m * 16 + fr) * 2 + bj) * 4 + wc] = ss; }
            asm volatile("s_waitcnt lgkmcnt(0)" ::: "memory"); __builtin_amdgcn_s_barrier(); asm volatile("" ::: "memory");
            const float* tab = rope + (p ? 8192 : 0); const int sin_off = p ? 2048 : 4096;
#pragma unroll
            for (int ai = 0; ai < 2; ++ai)
#pragma unroll
                for (int m = 0; m < 4; ++m) { const int r = row0 + ai * HALF + m * 16; const int t = r < SEQ_P ? r : (r - SEQ_P) & (SEQ_S - 1);
                    const float* tp = tab + (p ? (t & 63) : (t >> 6)) * 32 + i0; const f32x4 cs = *(const f32x4*)tp, sn = *(const f32x4*)(tp + sin_off);
#pragma unroll
                    for (int bj = 0; bj < 2; ++bj) { unsigned char* dst = (u.pn < 8 ? qa8 + (size_t)r * 2048 + (2 * u.pn + bj) * HD : ka8 + (size_t)r * 512 + (2 * (u.pn - 8) + bj) * HD) + 64 * p + i0; const f32x4 q4 = *(const LAS f32x4*)(xs + ((ai * HALF + wr * 64 + m * 16 + fr) * 2 + bj) * 4);
                        const float rs = 1.0f / sqrtf(((q4[0] + q4[1]) + (q4[2] + q4[3])) * (1.0f / HD) + RMS_EPS);
                        const f32x4 x1 = acc[ai][bj][m][0] * rs * g1, x2 = acc[ai][bj][m][1] * rs * g2;
                        const f32x4 y1 = x1 * cs - x2 * sn, y2 = x2 * cs + x1 * sn;
                        const float SC = (float)(1 << L_QK) * (u.pn < 8 ? Q_PRE : 1.0f);
                        *(unsigned*)dst = pk4_fp8(y1[0] * SC, y1[1] * SC, y1[2] * SC, y1[3] * SC); *(unsigned*)(dst + 32) = pk4_fp8(y2[0] * SC, y2[1] * SC, y2[2] * SC, y2[3] * SC); } }
            return;
        }
        if (u.pn == 10 || u.pn == 11 || u.pn == 22 || u.pn == 23) {
            unsigned char* const vt = u.pn < 12 ? vt8 : vtb8; const int h0 = 2 * (u.pn < 12 ? u.pn - 10 : u.pn - 22);
            constexpr float SC = (float)(1 << L_QK);
#pragma unroll
            for (int ai = 0; ai < 2; ++ai)
#pragma unroll
                for (int m = 0; m < 4; ++m) { const int r = row0 + ai * HALF + m * 16; const int gb = r >> 6, pos = kpos(r & 63);
#pragma unroll
                    for (int bj = 0; bj < 2; ++bj) { unsigned char* vb = vt + ((size_t)(gb * 4 + h0 + bj) * HD + wc * 32 + 8 * fq) * 64 + pos;
                        const f32x4 v0 = acc[ai][bj][m][0] * SC, v1 = acc[ai][bj][m][1] * SC; const unsigned w0 = pk4_fp8(v0[0], v0[1], v0[2], v0[3]), w1 = pk4_fp8(v1[0], v1[1], v1[2], v1[3]);
#pragma unroll
                        for (int e = 0; e < 4; ++e) { vb[e * 64] = (unsigned char)(w0 >> (8 * e)); vb[(4 + e) * 64] = (unsigned char)(w1 >> (8 * e)); } } }
            return;
        }
        const int col0 = u.pn * BM + wc * 32 + 8 * fq; const bool sig = u.pn * BM >= C_GA;
        if (!sig) {
            const bool isq = u.pn < 20; const float SC = (float)(1 << L_QK) * (isq ? Q_PRE : 1.0f);
#pragma unroll
            for (int ai = 0; ai < 2; ++ai)
#pragma unroll
                for (int m = 0; m < 4; ++m) { const size_t r = (size_t)(row0 + ai * HALF + m * 16);
                    unsigned char* dst = isq ? qb8 + r * 2048 + (col0 - C_QB) : kb8 + r * 512 + (col0 - C_KB);
#pragma unroll
                    for (int bj = 0; bj < 2; ++bj) { const f32x4 v0 = acc[ai][bj][m][0] * SC, v1 = acc[ai][bj][m][1] * SC;
                        v2u w; w.x = pk4_fp8(v0[0], v0[1], v0[2], v0[3]); w.y = pk4_fp8(v1[0], v1[1], v1[2], v1[3]); *(v2u*)(dst + bj * HALF) = w; } }
            return;
        }
#pragma unroll
        for (int ai = 0; ai < 2; ++ai)
#pragma unroll
            for (int m = 0; m < 4; ++m) { bf16* rowp = O + (size_t)(row0 + ai * HALF + m * 16) * IN_W + col0;
#pragma unroll
                for (int bj = 0; bj < 2; ++bj) { f32x4 v0 = acc[ai][bj][m][0], v1 = acc[ai][bj][m][1];
                    if (sig) {
#pragma unroll
                        for (int e = 0; e < 4; ++e) { v0[e] = sigmoidf_(v0[e]); v1[e] = sigmoidf_(v1[e]); }
                        v2u g; g.x = pk4_gate(v0[0], v0[1], v0[2], v0[3]); g.y = pk4_gate(v1[0], v1[1], v1[2], v1[3]);
                        *(v2u*)((unsigned char*)(rowp - col0) + GATE_B0 + (col0 - C_GA) + bj * HALF) = g; }
                    else { v4u w; w.x = cvt_pk_bf16(v0[0], v0[1]); w.y = cvt_pk_bf16(v0[2], v0[3]); w.z = cvt_pk_bf16(v1[0], v1[1]); w.w = cvt_pk_bf16(v1[2], v1[3]);
                        *(v4u*)(rowp + bj * HALF) = w; } } }
    }
};
struct EpiMerge {
    static constexpr bool PERM = true, PAIRED = true;
    const bf16* P; unsigned char* O;
    __device__ __forceinline__ void mid(Acc& acc, const Unit& u, int wr, int wc, int fr, int fq) const {
        const int row0 = u.pm * BM + wr * 64 + fr, col0 = u.pn * BM + wc * 32 + 8 * fq;
#pragma unroll
        for (int ai = 0; ai < 2; ++ai)
#pragma unroll
            for (int m = 0; m < 4; ++m) { const unsigned char* gp = (const unsigned char*)(P + (size_t)(row0 + ai * HALF + m * 16) * IN_W) + GATE_B0 + col0;
#pragma unroll
                for (int bj = 0; bj < 2; ++bj) { const v2u a = *(const v2u*)(gp + bj * HALF), b = *(const v2u*)(gp + DM + bj * HALF);
#define GM_(n, e, AW, BW, K) acc[ai][bj][m][n][e] *= gate_f<K>(AW) * __builtin_amdgcn_rcpf(gate_f<K>(BW))
                    GM_(0, 0, a.x, b.x, 0); GM_(0, 1, a.x, b.x, 1); GM_(0, 2, a.x, b.x, 2); GM_(0, 3, a.x, b.x, 3); GM_(1, 0, a.y, b.y, 0); GM_(1, 1, a.y, b.y, 1); GM_(1, 2, a.y, b.y, 2); GM_(1, 3, a.y, b.y, 3);
#undef GM_
                } }
    }
    __device__ __forceinline__ void operator()(const Acc& acc, const Unit& u, int wr, int wc, int fr, int fq) const {
        const int row0 = u.pm * BM + wr * 64 + fr, col0 = u.pn * BM + wc * 32 + 8 * fq;
        v2u gb[2][4][2];
#pragma unroll
        for (int ai = 0; ai < 2; ++ai)
#pragma unroll
            for (int m = 0; m < 4; ++m) { const size_t r = (size_t)(row0 + ai * HALF + m * 16);
#pragma unroll
                for (int bj = 0; bj < 2; ++bj) gb[ai][m][bj] = *(const v2u*)((const unsigned char*)(P + r * IN_W) + GATE_B0 + DM + col0 + bj * HALF); }
        asm volatile("" ::: "memory");
#pragma unroll
        for (int ai = 0; ai < 2; ++ai)
#pragma unroll
            for (int m = 0; m < 4; ++m) { const size_t r = (size_t)(row0 + ai * HALF + m * 16);
#pragma unroll
                for (int bj = 0; bj < 2; ++bj) { const v2u b = gb[ai][m][bj];
                    const float s[8] = {gate_f<0>(b.x), gate_f<1>(b.x), gate_f<2>(b.x), gate_f<3>(b.x), gate_f<0>(b.y), gate_f<1>(b.y), gate_f<2>(b.y), gate_f<3>(b.y)};
                    const f32x4 v0 = acc[ai][bj][m][0], v1 = acc[ai][bj][m][1]; constexpr float SC = (float)(1 << L_MG);
                    v2u w; w.x = pk4_fp8(v0[0] * s[0] * SC, v0[1] * s[1] * SC, v0[2] * s[2] * SC, v0[3] * s[3] * SC); w.y = pk4_fp8(v1[0] * s[4] * SC, v1[1] * s[5] * SC, v1[2] * s[6] * SC, v1[3] * s[7] * SC);
                    *(v2u*)(O + r * DM + col0 + bj * HALF) = w; } }
    }
};
template <bool XH> struct EpiRes {
    static constexpr bool PERM = true, PAIRED = false;
    const float* xp; const float* xs; const unsigned short* xh; unsigned short* out; const float* gate;
    __device__ __forceinline__ void operator()(const Acc& acc, const Unit& u, int wr, int wc, int fr, int fq) const {
        const int row0 = u.pm * BM + wr * 64 + fr, col0 = u.pn * BM + wc * 32 + 8 * fq;
        const int b = u.pm < 32 ? 0 : 1 + ((u.pm - 32) >> 4);
        const float* xb = u.pm < 32 ? xp : xs - (size_t)SEQ_P * DM;
        const float* gp = gate + (size_t)b * NMOD * DM + col0;
        f32x4 gv[2][2];
#pragma unroll
        for (int bj = 0; bj < 2; ++bj)
#pragma unroll
            for (int n = 0; n < 2; ++n) gv[bj][n] = *(const f32x4*)(gp + bj * HALF + n * 4);
#pragma unroll
        for (int ai = 0; ai < 2; ++ai) {
            f32x4 xv[4][2][2]; v4u hv[4][2];
#pragma unroll
            for (int m = 0; m < 4; ++m) { const size_t off = (size_t)(row0 + ai * HALF + m * 16) * DM + col0;
#pragma unroll
                for (int bj = 0; bj < 2; ++bj) {
                    if constexpr (XH) hv[m][bj] = *(const v4u*)(xh + off + bj * HALF);
                    else { xv[m][bj][0] = *(const f32x4*)(xb + off + bj * HALF); xv[m][bj][1] = *(const f32x4*)(xb + off + bj * HALF + 4); } } }
            asm volatile("" ::: "memory");
#pragma unroll
            for (int m = 0; m < 4; ++m) { const size_t off = (size_t)(row0 + ai * HALF + m * 16) * DM + col0;
#pragma unroll
                for (int bj = 0; bj < 2; ++bj) { f32x4 x0, x1;
                    if constexpr (XH) { const v4u h = hv[m][bj]; x0 = (f32x4){h_lo(h.x), h_hi(h.x), h_lo(h.y), h_hi(h.y)}; x1 = (f32x4){h_lo(h.z), h_hi(h.z), h_lo(h.w), h_hi(h.w)}; }
                    else { x0 = xv[m][bj][0]; x1 = xv[m][bj][1]; }
                    const f32x4 t0 = x0 * ALPHA + gv[bj][0] * acc[ai][bj][m][0], t1 = x1 * ALPHA + gv[bj][1] * acc[ai][bj][m][1];
                    v4u w; w.x = pk_h2(t0[0], t0[1]); w.y = pk_h2(t0[2], t0[3]); w.z = pk_h2(t1[0], t1[1]); w.w = pk_h2(t1[2], t1[3]);
                    __builtin_nontemporal_store(w, (v4u*)(out + off + bj * HALF)); } }
            asm volatile("" ::: "memory");
        }
    }
};
struct EpiSwiglu {
    static constexpr bool PERM = true, PAIRED = false;
    bf16* O; const float* rs; const float* cs;
    __device__ __forceinline__ void operator()(const Acc& acc, const Unit& u, int wr, int wc, int fr, int fq) const {
        const int row0 = u.pm * BM + wr * 64 + fr, col0 = u.pn * HALF + wc * 32 + 8 * fq;
        const float* cp = cs + u.pn * BM + wc * 32 + 8 * fq;
        const f32x4 cg0 = *(const f32x4*)cp, cg1 = *(const f32x4*)(cp + 4), cu0 = *(const f32x4*)(cp + HALF), cu1 = *(const f32x4*)(cp + HALF + 4);
        float rsv[2][4];
#pragma unroll
        for (int ai = 0; ai < 2; ++ai)
#pragma unroll
            for (int m = 0; m < 4; ++m) rsv[ai][m] = rs[row0 + ai * HALF + m * 16];
        asm volatile("" ::: "memory");
#pragma unroll
        for (int ai = 0; ai < 2; ++ai)
#pragma unroll
            for (int m = 0; m < 4; ++m) { float v[8]; const int r = row0 + ai * HALF + m * 16; const float rsc = rsv[ai][m];
#pragma unroll
                for (int n = 0; n < 2; ++n)
#pragma unroll
                    for (int e = 0; e < 4; ++e) { const float g = (float)__float_as_int(acc[ai][0][m][n][e]) * (rsc * (n ? cg1[e] : cg0[e])), up = (float)__float_as_int(acc[ai][1][m][n][e]) * (rsc * (n ? cu1[e] : cu0[e])); v[n * 4 + e] = g * sigmoidf_(g) * up; }
                v4u w; w.x = cvt_pk_bf16(v[0], v[1]); w.y = cvt_pk_bf16(v[2], v[3]); w.z = cvt_pk_bf16(v[4], v[5]); w.w = cvt_pk_bf16(v[6], v[7]);
                __builtin_nontemporal_store(w, (v4u*)(O + (size_t)r * DFF + col0)); }
    }
};

template <class Epi, bool INT> struct EpiHalf {
    static constexpr bool PERM = Epi::PERM, PAIRED = true; Epi e;
    __device__ __forceinline__ void mid(Acc&, const Unit&, int, int, int, int) const {}
    __device__ __forceinline__ void operator()(Acc& acc, const Unit& u, int wr, int wc, int fr, int fq) const {
#pragma unroll
        for (int a = 0; a < 2; ++a)
#pragma unroll
            for (int b = 0; b < 2; ++b)
#pragma unroll
                for (int m = 0; m < 4; ++m)
#pragma unroll
                    for (int n = 0; n < 2; ++n)
#pragma unroll
                        for (int q = 0; q < 4; ++q) { if (INT) acc[a][b][m][n][q] = __int_as_float(__float_as_int(acc[a][b][m][n][q]) >> 1); else acc[a][b][m][n][q] *= 0.5f; }
        e(acc, u, wr, wc, fr, fq);
    }
};
template <class Epi, class Sched, int GM>
__device__ __forceinline__ void gemm_phase(LAS unsigned char* lds, const Gemm g, const Sched& S, Epi E) {
    const int tid = tid_fresh(), wid = __builtin_amdgcn_readfirstlane(tid >> 6), lane = tid & 63, wr = wid >> 2, wc = wid & 3, fr = lane & 15, fq = lane >> 4;
    constexpr bool F8 = GM == 1;
    const int nt = g.kbytes / (BK * 2);
    const int sclA = g.sa, sclB = g.sb;
    unsigned voffA[2], voffB[2];
#pragma unroll
    for (int i = 0; i < 2; ++i) { int R, C; stage_rc(tid * 16 + i * 8192, R, C); const int Rb = Epi::PERM ? ((R & ~31) + perm32(R & 31)) : R;
        voffA[i] = (unsigned)(R * g.lda + C * 2); voffB[i] = (unsigned)(Rb * g.ldb + C * 2); }
    const size_t kstep = (size_t)(BK * 2);
    const size_t hstepA = (size_t)HALF * g.lda, hstepB = (size_t)HALF * g.ldb;
    const unsigned ldsw = (unsigned)wid * 1024u;
    const int aoff = lds_byte(wr * 64 + fr, fq * 8), boff = lds_byte(wc * 32 + fr, fq * 8);
#define PG8_SA(b, h) (((b) * 2 + (h)) * HTB)
#define PG8_SB(b, h) ((4 + (b) * 2 + (h)) * HTB)
#define PG8_STAGE(bufoff, gbase, voff) do { _Pragma("unroll") for (int _i = 0; _i < 2; ++_i) \
        __builtin_amdgcn_global_load_lds((const unsigned*)((const char*)(gbase) + (voff)[_i]), (LAS unsigned*)(lds + (bufoff) + ldsw + _i * 8192), 16, 0, 0); } while (0)
#define PG8_CAT(p) __builtin_shufflevector(*(const LAS v4i*)(p), *(const LAS v4i*)((p) + 1024), 0, 1, 2, 3, 4, 5, 6, 7)
#define PG8_LDA(dst, b, h) do { if constexpr (F8) { _Pragma("unroll") for (int m = 0; m < 4; ++m) dst##8[m] = PG8_CAT(lds + PG8_SA(b, h) + aoff + m * 2048); } \
        else { _Pragma("unroll") for (int m = 0; m < 4; ++m) _Pragma("unroll") for (int k = 0; k < 2; ++k) dst[m][k] = *(const LAS bf16x8*)(lds + PG8_SA(b, h) + aoff + m * 2048 + k * 1024); } } while (0)
#define PG8_LDB(dst, b, h) do { if constexpr (F8) { _Pragma("unroll") for (int n = 0; n < 2; ++n) dst##8[n] = PG8_CAT(lds + PG8_SB(b, h) + boff + n * 2048); } \
        else { _Pragma("unroll") for (int n = 0; n < 2; ++n) _Pragma("unroll") for (int k = 0; k < 2; ++k) dst[n][k] = *(const LAS bf16x8*)(lds + PG8_SB(b, h) + boff + n * 2048 + k * 1024); } } while (0)
#define PG8_MMA(ai, bj, At, Bt) do { __builtin_amdgcn_s_setprio(1); if constexpr (F8) { _Pragma("unroll") for (int m = 0; m < 4; ++m) _Pragma("unroll") for (int n = 0; n < 2; ++n) \
            asm volatile("v_mfma_scale_f32_16x16x128_f8f6f4 %0, %1, %2, %0, %3, %4 op_sel_hi:[0,0,0]" : "+v"(acc[ai][bj][m][n]) : "v"(Bt##8[n]), "v"(At##8[m]), "v"(sclB), "v"(sclA)); } \
        else if constexpr (GM == 2) { _Pragma("unroll") for (int m = 0; m < 4; ++m) _Pragma("unroll") for (int n = 0; n < 2; ++n) _Pragma("unroll") for (int k = 0; k < 2; ++k) \
        acc[ai][bj][m][n] = __builtin_bit_cast(f32x4, __builtin_amdgcn_mfma_i32_16x16x64_i8(__builtin_bit_cast(v4i, Bt[n][k]), __builtin_bit_cast(v4i, At[m][k]), __builtin_bit_cast(v4i, acc[ai][bj][m][n]), 0, 0, 0)); } \
        else { _Pragma("unroll") for (int m = 0; m < 4; ++m) _Pragma("unroll") for (int n = 0; n < 2; ++n) _Pragma("unroll") for (int k = 0; k < 2; ++k) \
        acc[ai][bj][m][n] = __builtin_amdgcn_mfma_f32_16x16x32_bf16(Bt[n][k], At[m][k], acc[ai][bj][m][n], 0, 0, 0); } __builtin_amdgcn_s_setprio(0); } while (0)
#define PG8_WAIT_V(n) asm volatile("s_waitcnt vmcnt(" #n ")" ::: "memory")
#define PG8_WAIT_L(n) asm volatile("s_waitcnt lgkmcnt(" #n ")" ::: "memory")
#define PG8_BAR __builtin_amdgcn_s_barrier()
#define PG8_SCHED __builtin_amdgcn_sched_barrier(0)
#define PG8_UA(u) ((const char*)g.A + (size_t)(u).pm * 2 * hstepA + (size_t)(u).kh * g.khoff)
#define PG8_UB(u) ((const char*)g.Bt + (size_t)(u).pn * 2 * hstepB + (size_t)(u).kh * g.khoff)
    Unit cur, nxt; int ui = 0;
    if (!S.next(0, cur)) return;
    Acc acc;
#pragma unroll
    for (int a = 0; a < 2; ++a)
#pragma unroll
        for (int b = 0; b < 2; ++b)
#pragma unroll
            for (int m = 0; m < 4; ++m)
#pragma unroll
                for (int n = 0; n < 2; ++n) acc[a][b][m][n] = (f32x4){0.f, 0.f, 0.f, 0.f};
    bf16x8 At[4][2], B0[2][2], B1[2][2]; v8i At8[4], B08[2], B18[2];
    const char* cA = PG8_UA(cur); const char* cB = PG8_UB(cur);
    PG8_STAGE(PG8_SB(0, 0), cB, voffB); PG8_STAGE(PG8_SB(0, 1), cB + hstepB, voffB); PG8_STAGE(PG8_SA(0, 0), cA, voffA); PG8_STAGE(PG8_SA(0, 1), cA + hstepA, voffA);
    if (wr == 1) PG8_BAR;
    PG8_WAIT_V(2); PG8_BAR;
    PG8_STAGE(PG8_SB(1, 0), cB + kstep, voffB); PG8_STAGE(PG8_SA(1, 0), cA + kstep, voffA); PG8_STAGE(PG8_SB(1, 1), cB + hstepB + kstep, voffB);
    PG8_WAIT_V(6); PG8_BAR;
    for (;;) {
        const bool has_next = S.next(ui + 1, nxt);
        const char* nA = has_next ? PG8_UA(nxt) : cA; const char* nB = has_next ? PG8_UB(nxt) : cB;
        for (int t = 0; t < nt; t += 2) {
            const bool last = (t == nt - 2);
            const char* a1 = cA + (size_t)(t + 1) * kstep;
            const char* a2 = last ? nA : cA + (size_t)(t + 2) * kstep; const char* b2 = last ? nB : cB + (size_t)(t + 2) * kstep;
            const char* a3 = a2 + kstep; const char* b3 = b2 + kstep;
            PG8_LDB(B0, 0, 0); PG8_LDB(B1, 0, 1); PG8_SCHED; PG8_LDA(At, 0, 0); PG8_STAGE(PG8_SA(1, 1), a1 + hstepA, voffA);
            PG8_WAIT_V(8); PG8_WAIT_L(0); PG8_BAR; PG8_MMA(0, 0, At, B0); PG8_MMA(0, 1, At, B1); PG8_BAR; PG8_SCHED;
            PG8_LDA(At, 0, 1); PG8_STAGE(PG8_SB(0, 0), b2, voffB); PG8_STAGE(PG8_SB(0, 1), b2 + hstepB, voffB); PG8_STAGE(PG8_SA(0, 0), a2, voffA);
            PG8_WAIT_V(8); PG8_WAIT_L(0); PG8_BAR; PG8_MMA(1, 0, At, B0); PG8_MMA(1, 1, At, B1); PG8_BAR; PG8_SCHED;
            PG8_LDB(B0, 1, 0); PG8_LDB(B1, 1, 1); PG8_SCHED; PG8_LDA(At, 1, 0); PG8_STAGE(PG8_SA(0, 1), a2 + hstepA, voffA);
            PG8_WAIT_V(8); PG8_WAIT_L(0); PG8_BAR; PG8_MMA(0, 0, At, B0); PG8_MMA(0, 1, At, B1); PG8_BAR; PG8_SCHED;
            PG8_LDA(At, 1, 1); PG8_STAGE(PG8_SB(1, 0), b3, voffB); PG8_STAGE(PG8_SB(1, 1), b3 + hstepB, voffB); PG8_STAGE(PG8_SA(1, 0), a3, voffA);
            PG8_WAIT_V(8); PG8_WAIT_L(0); PG8_BAR; PG8_MMA(1, 0, At, B0); PG8_MMA(1, 1, At, B1); PG8_BAR; PG8_SCHED;
        }
        if constexpr (F8) asm volatile("s_nop 7\n\ts_nop 7\n\ts_nop 7" ::: "memory");
        if (wr == 0) PG8_BAR;
        bool keep = false;
        if constexpr (Epi::PAIRED) { if (cur.kh == 0) { E.mid(acc, cur, wr, wc, fr, fq); keep = true; } }
        if (!keep) E(acc, cur, wr, wc, fr, fq);
        if (!has_next) break;
        if (!keep) {
#pragma unroll
            for (int a = 0; a < 2; ++a)
#pragma unroll
                for (int b = 0; b < 2; ++b)
#pragma unroll
                    for (int m = 0; m < 4; ++m)
#pragma unroll
                        for (int n = 0; n < 2; ++n) acc[a][b][m][n] = (f32x4){0.f, 0.f, 0.f, 0.f};
        }
        cur = nxt; cA = nA; cB = nB; ++ui;
        if (wr == 1) PG8_BAR;
    }
    PG8_WAIT_V(0);
    PG8_BAR;
#undef PG8_SA
#undef PG8_SB
#undef PG8_STAGE
#undef PG8_LDA
#undef PG8_CAT
#undef PG8_LDB
#undef PG8_MMA
#undef PG8_WAIT_V
#undef PG8_WAIT_L
#undef PG8_BAR
#undef PG8_SCHED
#undef PG8_UA
#undef PG8_UB
}
}

namespace att {
constexpr int D = 128, NW = 8, QBLK = 32, KVBLK = 64;
constexpr float SCALE = ATT_SCALE, THR = 8.f;
constexpr int LDQ = IN_W, LDK = IN_W, LDO = DM;
constexpr int SHM_V = KVBLK * D * 2, SHM_K = KVBLK * D * 2, SHM_ATTN = 2 * SHM_V + 2 * SHM_K + NW * 64 * 4;
#define KSWZ(row, colB) ((row) * 256 + ((colB) ^ (((row) & 7) << 4)))
#define SBAR() __builtin_amdgcn_sched_barrier(0)
__device__ __forceinline__ int crow(int r, int hi) { return (r & 3) + 8 * (r >> 2) + 4 * hi; }
__device__ __forceinline__ void partialSM(f32x16& p0, f32x16& p1, float& m_reg, float& mn, float& alpha) {
  constexpr float C = SCALE * 1.4426950408889634f;
  float pmax = p0[0];
#pragma unroll
  for (int r = 1; r < 16; ++r) pmax = fmaxf(pmax, p0[r]);
#pragma unroll
  for (int r = 0; r < 16; ++r) pmax = fmaxf(pmax, p1[r]);
  { auto rr = __builtin_amdgcn_permlane32_swap(__float_as_uint(pmax), __float_as_uint(pmax), false, false);
    pmax = fmaxf(__uint_as_float(rr[0]), __uint_as_float(rr[1])); }
  if (__builtin_expect(__all(pmax - m_reg <= THR / SCALE), 1)) { mn = m_reg; alpha = 1.f; }
  else { mn = fmaxf(m_reg, pmax); alpha = __builtin_amdgcn_exp2f((m_reg - mn) * C); m_reg = mn; }
  float mnC = -mn * C;
#pragma unroll
  for (int r = 0; r < 16; ++r) p0[r] = fmaf(p0[r], C, mnC);
#pragma unroll
  for (int r = 0; r < 16; ++r) p1[r] = fmaf(p1[r], C, mnC);
#pragma unroll
  for (int r = 0; r < 16; ++r) p0[r] = __builtin_amdgcn_exp2f(p0[r]);
}
__device__ __forceinline__ void finishSM(f32x16& p0, f32x16& p1, float alpha, float& l_reg, bf16x8& pa0, bf16x8& pa1, bf16x8& pa2, bf16x8& pa3) {
#pragma unroll
  for (int r = 0; r < 16; ++r) p1[r] = __builtin_amdgcn_exp2f(p1[r]);
  float ps = 0;
#pragma unroll
  for (int r = 0; r < 16; ++r) ps += p0[r];
#pragma unroll
  for (int r = 0; r < 16; ++r) ps += p1[r];
  { auto rr = __builtin_amdgcn_permlane32_swap(__float_as_uint(ps), __float_as_uint(ps), false, false);
    ps = __uint_as_float(rr[0]) + __uint_as_float(rr[1]); }
  l_reg = l_reg * alpha + ps;
#define PK4(P, BASE, OUT) do { unsigned a0 = cvt_pk_bf16(P[BASE + 0], P[BASE + 1]), a1 = cvt_pk_bf16(P[BASE + 2], P[BASE + 3]);   \
    unsigned b0 = cvt_pk_bf16(P[BASE + 4], P[BASE + 5]), b1 = cvt_pk_bf16(P[BASE + 6], P[BASE + 7]);                              \
    auto r0 = __builtin_amdgcn_permlane32_swap(a0, b0, false, false); auto r1 = __builtin_amdgcn_permlane32_swap(a1, b1, false, false); \
    v4u w = {r0[0], r1[0], r0[1], r1[1]}; OUT = *reinterpret_cast<bf16x8*>(&w); } while (0)
  PK4(p0, 0, pa0); PK4(p0, 8, pa1); PK4(p1, 0, pa2); PK4(p1, 8, pa3);
#undef PK4
}
__device__ __forceinline__ void qkt(f32x16& p0, f32x16& p1, const char* Ks, const bf16x8* qr, int r32, int hi) {
  p0 = f32x16{}; p1 = f32x16{};
#pragma unroll
  for (int d0 = 0; d0 < 8; ++d0) { int cb = (d0 * 16 + hi * 8) * 2;
    bf16x8 b0 = *reinterpret_cast<const bf16x8*>(Ks + KSWZ(r32, cb));
    bf16x8 b1 = *reinterpret_cast<const bf16x8*>(Ks + KSWZ(32 + r32, cb));
    p0 = __builtin_amdgcn_mfma_f32_32x32x16_bf16(b0, qr[d0], p0, 0, 0, 0);
    p1 = __builtin_amdgcn_mfma_f32_32x32x16_bf16(b1, qr[d0], p1, 0, 0, 0); }
}
__device__ __forceinline__ void win_bias(f32x16& p0, f32x16& p1, int dq, float sl) {
  const float NEG = -__builtin_inff();
#pragma unroll
  for (int r = 0; r < 16; ++r) { const int c = (r & 3) + 8 * (r >> 2);
    const int d0 = dq - c, d1 = dq - c - 32; const int a0 = d0 < 0 ? -d0 : d0, a1 = d1 < 0 ? -d1 : d1;
    p0[r] = a0 <= 128 ? fmaf(-sl, (float)a0, p0[r]) : NEG;
    p1[r] = a1 <= 128 ? fmaf(-sl, (float)a1, p1[r]) : NEG; }
}
__device__ __forceinline__ int v_st(int k, int c) { const int kk = (k & ~0xC) | ((k & 4) << 1) | ((k & 8) >> 1); return ((kk >> 3) * 4 + (c >> 5)) * 512 + ((kk & 7) * 32 + (c & 31)) * 2; }
__device__ __forceinline__ int v_rd_base(int lane) { return ((lane & 3) << 3) | (((lane >> 2) & 3) << 6) | (((lane >> 4) & 1) << 5) | (((lane >> 5) & 1) << 8); }
constexpr int v_rd_off(int d0, int ks, int half) { return d0 * 512 + ks * 4096 + half * 2048; }
template <int OFF> __device__ __forceinline__ s16x4 tr_read(int vb) {
  s16x4 r; asm volatile("ds_read_b64_tr_b16 %0, %1 offset:%2" : "=&v"(r) : "v"(vb), "i"(OFF) : "memory"); return r;
}
template <int D0> __device__ __forceinline__ void pv_one(f32x16& od, int vb, bf16x8 pa0, bf16x8 pa1, bf16x8 pa2, bf16x8 pa3) {
  const s16x4 l0 = tr_read<v_rd_off(D0, 0, 0)>(vb), h0 = tr_read<v_rd_off(D0, 0, 1)>(vb), l1 = tr_read<v_rd_off(D0, 1, 0)>(vb), h1 = tr_read<v_rd_off(D0, 1, 1)>(vb);
  const s16x4 l2 = tr_read<v_rd_off(D0, 2, 0)>(vb), h2 = tr_read<v_rd_off(D0, 2, 1)>(vb), l3 = tr_read<v_rd_off(D0, 3, 0)>(vb), h3 = tr_read<v_rd_off(D0, 3, 1)>(vb);
  asm volatile("s_waitcnt lgkmcnt(0)" ::: "memory"); SBAR();
#define PK(L, H) (bf16x8){L[0], L[1], L[2], L[3], H[0], H[1], H[2], H[3]}
  od = __builtin_amdgcn_mfma_f32_32x32x16_bf16(PK(l0, h0), pa0, od, 0, 0, 0);
  od = __builtin_amdgcn_mfma_f32_32x32x16_bf16(PK(l1, h1), pa1, od, 0, 0, 0);
  od = __builtin_amdgcn_mfma_f32_32x32x16_bf16(PK(l2, h2), pa2, od, 0, 0, 0);
  od = __builtin_amdgcn_mfma_f32_32x32x16_bf16(PK(l3, h3), pa3, od, 0, 0, 0);
#undef PK
}
__device__ __forceinline__ void pv_d0(f32x16* o, int vb, bf16x8 pa0, bf16x8 pa1, bf16x8 pa2, bf16x8 pa3) {
  pv_one<0>(o[0], vb, pa0, pa1, pa2, pa3); pv_one<1>(o[1], vb, pa0, pa1, pa2, pa3); pv_one<2>(o[2], vb, pa0, pa1, pa2, pa3); pv_one<3>(o[3], vb, pa0, pa1, pa2, pa3);
}
template <int MODE, int SDEPTH>
__device__ __forceinline__ void attn_body(const bf16* __restrict__ Qb, const bf16* __restrict__ Kh, const bf16* __restrict__ Vh, unsigned char* __restrict__ Ob, int NT, char* lds, int qrel, float sl, float sink_raw) {
  const int tid = tid_fresh(), wid = tid >> 6, lane = tid & 63, r32 = lane & 31, hi = lane >> 5;
  char* V_lds = lds; char* K_lds = lds + 2 * SHM_V;
  float m_reg = MODE ? sink_raw : -1e30f, l_reg = MODE ? 1.f : 0.f; f32x16 o[4] = {}; bf16x8 qr[8];
  const int dq0 = qrel + wid * QBLK + r32 - 4 * hi;
  const bf16* Qw = Qb + (long)(wid * QBLK + r32) * LDQ + hi * 8;
#pragma unroll
  for (int d0 = 0; d0 < 8; ++d0) qr[d0] = *reinterpret_cast<const bf16x8*>(Qw + d0 * 16);
  const int sr = tid >> 4, sc = (tid & 15) * 8, vst0 = v_st(sr, sc), vst1 = v_st(32 + sr, sc);
  const int vb0 = (int)(uintptr_t)V_lds + v_rd_base(lane);
  struct { bf16x8 vs0, vs1, ks0, ks1; } sr_[SDEPTH];
#define SLOAD(i, k0) do { sr_[i].vs0 = *reinterpret_cast<const bf16x8*>(&Vh[(long)((k0) + sr) * LDK + sc]); sr_[i].vs1 = *reinterpret_cast<const bf16x8*>(&Vh[(long)((k0) + 32 + sr) * LDK + sc]); \
    sr_[i].ks0 = *reinterpret_cast<const bf16x8*>(&Kh[(long)((k0) + sr) * LDK + sc]); sr_[i].ks1 = *reinterpret_cast<const bf16x8*>(&Kh[(long)((k0) + 32 + sr) * LDK + sc]); } while (0)
#define SWRITE(b, i) do { *(bf16x8*)(V_lds + (b) * SHM_V + vst0) = sr_[i].vs0;          \
    *(bf16x8*)(V_lds + (b) * SHM_V + vst1) = sr_[i].vs1; int kc = sc * 2;               \
    *(bf16x8*)(K_lds + (b) * SHM_K + KSWZ(sr, kc)) = sr_[i].ks0;                       \
    *(bf16x8*)(K_lds + (b) * SHM_K + KSWZ(32 + sr, kc)) = sr_[i].ks1; } while (0)
#define SWAIT() do { if constexpr (SDEPTH == 2) asm volatile("s_waitcnt vmcnt(4)" ::: "memory"); else asm volatile("s_waitcnt vmcnt(0)" ::: "memory"); } while (0)
#define RESC(a) do { if (__any((a) < 1.f)) { _Pragma("unroll") for (int d = 0; d < 4; ++d) _Pragma("unroll") for (int r = 0; r < 16; ++r) o[d][r] *= (a); } } while (0)
#define WB(P0, P1, j) do { if (MODE) win_bias(P0, P1, dq0 - (j) * KVBLK, sl); } while (0)
  f32x16 pA0, pA1, pB0, pB1; float mnA, mnB, alA, alB; bf16x8 pa0, pa1, pa2, pa3;
  constexpr int SE = 0, SO = SDEPTH - 1;
  SLOAD(SE, 0); asm volatile("s_waitcnt vmcnt(0)" ::: "memory"); SWRITE(0, SE);
  if constexpr (SDEPTH == 1) SLOAD(SO, KVBLK);
  __syncthreads();
  qkt(pA0, pA1, K_lds, qr, r32, hi); WB(pA0, pA1, 0); partialSM(pA0, pA1, m_reg, mnA, alA);
  if constexpr (SDEPTH == 2) { SLOAD(SO, KVBLK); if (2 < NT) SLOAD(SE, 2 * KVBLK); }
  SWAIT(); SWRITE(1, SO); __syncthreads();
  for (int j = 1; j + 1 < NT; j += 2) {
    SBAR(); qkt(pB0, pB1, K_lds + SHM_K, qr, r32, hi);
    finishSM(pA0, pA1, alA, l_reg, pa0, pa1, pa2, pa3); SBAR();
    SLOAD(SO, (j + SDEPTH) * KVBLK); SBAR();
    pv_d0(o, vb0, pa0, pa1, pa2, pa3); WB(pB0, pB1, j); partialSM(pB0, pB1, m_reg, mnB, alB);
    __syncthreads(); SWAIT(); SWRITE(0, SE);
    RESC(alB); __syncthreads();
    SBAR(); qkt(pA0, pA1, K_lds, qr, r32, hi);
    finishSM(pB0, pB1, alB, l_reg, pa0, pa1, pa2, pa3); SBAR();
    if (SDEPTH == 1 || j + 3 < NT) SLOAD(SE, (j + 1 + SDEPTH) * KVBLK); SBAR();
    pv_d0(o, vb0 + (int)SHM_V, pa0, pa1, pa2, pa3); WB(pA0, pA1, j + 1); partialSM(pA0, pA1, m_reg, mnA, alA);
    __syncthreads(); SWAIT(); SWRITE(1, SO);
    RESC(alA); __syncthreads();
  }
  SBAR(); qkt(pB0, pB1, K_lds + SHM_K, qr, r32, hi);
  finishSM(pA0, pA1, alA, l_reg, pa0, pa1, pa2, pa3); SBAR();
  pv_d0(o, vb0, pa0, pa1, pa2, pa3); WB(pB0, pB1, NT - 1); partialSM(pB0, pB1, m_reg, mnB, alB);
  __syncthreads(); RESC(alB);
  finishSM(pB0, pB1, alB, l_reg, pa0, pa1, pa2, pa3); SBAR();
  pv_d0(o, vb0 + (int)SHM_V, pa0, pa1, pa2, pa3);
  { const float rl = __builtin_amdgcn_rcpf(l_reg) * (float)(1 << L_Y);
    unsigned char* Ow = Ob + (long)(wid * QBLK + r32) * LDO + 4 * hi;
#pragma unroll
    for (int d0 = 0; d0 < 4; ++d0)
#pragma unroll
      for (int g = 0; g < 4; ++g) *(unsigned*)(Ow + d0 * 32 + 8 * g) = pk4_fp8(o[d0][4 * g] * rl, o[d0][4 * g + 1] * rl, o[d0][4 * g + 2] * rl, o[d0][4 * g + 3] * rl); }
#undef SLOAD
#undef SWRITE
#undef SWAIT
#undef RESC
#undef WB
}
}


namespace att8 {
typedef int v4i __attribute__((ext_vector_type(4)));
typedef int v8i __attribute__((ext_vector_type(8)));
constexpr float SCALE = ATT_SCALE, THR = 3.f;
constexpr int TB = 8192;
constexpr int SC8 = (127 - L_QK) * 0x01010101;
constexpr int SC8Q = (127 - L_QK - 3) * 0x01010101;
constexpr float THR2 = THR * 1.4426950408889634f;
#define CAT8(p) __builtin_shufflevector(*(const v4i*)(p), *(const v4i*)((p) + 16), 0, 1, 2, 3, 4, 5, 6, 7)
__device__ __forceinline__ v8i cat8x(const char* base, int off) { return __builtin_shufflevector(*(const v4i*)(base + off), *(const v4i*)(base + (off ^ 16)), 0, 1, 2, 3, 4, 5, 6, 7); }
template <bool FIRST>
__device__ __forceinline__ void softmax8(f32x16& p0, f32x16& p1, f32x16& ci, f32x16& ls, f32x16* o, v8i& P8) {
  float pmax = p0[0];
#pragma unroll
  for (int r = 1; r < 16; ++r) pmax = fmaxf(pmax, p0[r]);
#pragma unroll
  for (int r = 0; r < 16; ++r) pmax = fmaxf(pmax, p1[r]);
  { auto rr = __builtin_amdgcn_permlane32_swap(__float_as_uint(pmax), __float_as_uint(pmax), false, false);
    pmax = fmaxf(__uint_as_float(rr[0]), __uint_as_float(rr[1])); }
  if (FIRST || !__all(pmax <= THR2 + (float)L_QK)) {
    const float d = FIRST ? pmax - (float)L_QK : fmaxf(pmax - (float)L_QK, 0.f);
#pragma unroll
    for (int r = 0; r < 16; ++r) { p0[r] -= d; p1[r] -= d; ci[r] -= d; }
    if (!FIRST) { const float alpha = __builtin_amdgcn_exp2f(-d);
#pragma unroll
      for (int r = 0; r < 16; ++r) ls[r] *= alpha;
#pragma unroll
      for (int db = 0; db < 4; ++db)
#pragma unroll
        for (int r = 0; r < 16; ++r) o[db][r] *= alpha; }
  }
#pragma unroll
  for (int r = 0; r < 16; ++r) { p0[r] = __builtin_amdgcn_exp2f(p0[r]); p1[r] = __builtin_amdgcn_exp2f(p1[r]); }
#pragma unroll
  for (int k = 0; k < 4; ++k) { int w = P8[k]; w = __builtin_amdgcn_cvt_pk_fp8_f32(p0[4 * k], p0[4 * k + 1], w, false); w = __builtin_amdgcn_cvt_pk_fp8_f32(p0[4 * k + 2], p0[4 * k + 3], w, true); P8[k] = w; }
#pragma unroll
  for (int k = 0; k < 4; ++k) { int w = P8[4 + k]; w = __builtin_amdgcn_cvt_pk_fp8_f32(p1[4 * k], p1[4 * k + 1], w, false); w = __builtin_amdgcn_cvt_pk_fp8_f32(p1[4 * k + 2], p1[4 * k + 3], w, true); P8[4 + k] = w; }
}
__device__ __forceinline__ void qkt8(f32x16& p0, f32x16& p1, const char* Kt, const v8i (&q8)[2], int ka0, int ka1, const f32x16& ci, const v8i& k00, const v8i& k10) {
  p0 = __builtin_amdgcn_mfma_scale_f32_32x32x64_f8f6f4(k00, q8[0], ci, 0, 0, 0, SC8, 0, SC8Q);
  p1 = __builtin_amdgcn_mfma_scale_f32_32x32x64_f8f6f4(k10, q8[0], ci, 0, 0, 0, SC8, 0, SC8Q);
  p0 = __builtin_amdgcn_mfma_scale_f32_32x32x64_f8f6f4(cat8x(Kt, ka1), q8[1], p0, 0, 0, 0, SC8, 0, SC8Q);
  p1 = __builtin_amdgcn_mfma_scale_f32_32x32x64_f8f6f4(cat8x(Kt + 4096, ka1), q8[1], p1, 0, 0, 0, SC8, 0, SC8Q);
}
__device__ __forceinline__ void pv8(f32x16* o, const char* Vt, const v8i& P8, int va, f32x16& ls, const v8i& ones) {
#pragma unroll
  for (int db = 0; db < 4; ++db) o[db] = __builtin_amdgcn_mfma_scale_f32_32x32x64_f8f6f4(cat8x(Vt + db * 2048, va), P8, o[db], 0, 0, 0, SC8, 0, SC8);
  ls = __builtin_amdgcn_mfma_scale_f32_32x32x64_f8f6f4(ones, P8, ls, 0, 0, 0, 127 * 0x01010101, 0, 127 * 0x01010101);
}
template <int MODE>
__device__ __forceinline__ void attn_a8(const unsigned char* __restrict__ Q8, const unsigned char* __restrict__ K8, const unsigned char* __restrict__ VT, unsigned char* __restrict__ Ob, int NT, char* lds, int qrel, float sl, float sink_raw) {
  const int tid = tid_fresh(), wid = tid >> 6, lane = tid & 63, r32 = lane & 31, hi = lane >> 5;
  char* K_lds = lds; char* V_lds = lds + 4 * TB;
  const float m_reg = MODE ? sink_raw : 0.f; f32x16 o[4] = {}; v8i q8[2];
  f32x16 ls; v8i ones;
  { float l0 = MODE ? (float)(1 << L_QK) : 0.f; int one4 = 0x38383838; asm volatile("" : "+v"(l0), "+v"(one4));
#pragma unroll
    for (int r = 0; r < 16; ++r) ls[r] = l0;
#pragma unroll
    for (int r = 0; r < 8; ++r) ones[r] = one4; }
  f32x16 ci;
  { float c0 = (float)L_QK - m_reg; asm volatile("" : "+v"(c0));
#pragma unroll
    for (int r = 0; r < 16; ++r) ci[r] = c0; }
  const int dq0 = qrel + wid * 32 + r32 - 4 * hi;
#define WB8(P0, P1, j) do { if (MODE) att::win_bias(P0, P1, dq0 - (j) * 64, sl); } while (0)
  { const unsigned char* qp = Q8 + (long)(wid * 32 + r32) * 2048 + 32 * hi; q8[0] = CAT8(qp); q8[1] = CAT8(qp + 64); }
  const int swk = (r32 >> 1) & 7, swv = (r32 >> 2) & 3;
  const int ka0 = r32 * 128 + (((0 + 2 * hi) ^ swk) << 4), ka1 = r32 * 128 + (((4 + 2 * hi) ^ swk) << 4);
  const int va = r32 * 64 + (((2 * hi) ^ swv) << 4);
  const int kr = tid >> 3, vd = tid >> 2; const bool late = wid >= 4;
  const unsigned goK = (unsigned)(kr * 512 + (((tid & 7) ^ ((kr >> 1) & 7)) << 4)), goV = (unsigned)(vd * 64 + (((tid & 3) ^ ((vd >> 2) & 3)) << 4));
  LAS char* const Lw = (LAS char*)lds + __builtin_amdgcn_readfirstlane(wid) * 1024;
#define DMAK8(j, rb) __builtin_amdgcn_global_load_lds((const unsigned*)((const char*)K8 + (size_t)(j) * (64 * 512) + goK), (LAS unsigned*)(Lw + (rb)), 16, 0, 0)
#define DMAV8(j, rb) __builtin_amdgcn_global_load_lds((const unsigned*)((const char*)VT + (size_t)(j) * (4 * TB) + goV), (LAS unsigned*)(Lw + 4 * TB + (rb)), 16, 0, 0)
#define WAITV8(n) asm volatile("s_waitcnt vmcnt(" #n ") lgkmcnt(0)" ::: "memory")
#define BAR8() do { __builtin_amdgcn_s_barrier(); asm volatile("" ::: "memory"); } while (0)
  f32x16 p0, p1; v8i P8 = {}, kf0, kf1;
#define KPRE8(KR) do { kf0 = cat8x(K_lds + (KR), ka0); kf1 = cat8x(K_lds + (KR) + 4096, ka0); } while (0)
  __syncthreads();
  DMAK8(0, 0); DMAV8(0, 0); DMAK8(1, TB); DMAK8(2, 2 * TB); WAITV8(0); BAR8();
  if (late) BAR8();
  __builtin_amdgcn_s_setprio(1);
  KPRE8(0);
  qkt8(p0, p1, K_lds, q8, ka0, ka1, ci, kf0, kf1); __builtin_amdgcn_sched_barrier(0);
  DMAK8(3 < NT ? 3 : NT - 1, 3 < NT ? 3 * TB : 8 * TB); DMAV8(1, TB);
  WAITV8(2);
  __builtin_amdgcn_s_setprio(0); BAR8();
  WB8(p0, p1, 0); softmax8<MODE == 0>(p0, p1, ci, ls, o, P8); KPRE8(TB); BAR8();
#define STEP8(t, KR, VR, KN) do { const int t_ = (t); const bool sk = t_ + 3 < NT, sv = t_ + 1 < NT; \
    __builtin_amdgcn_s_setprio(1); \
    qkt8(p0, p1, K_lds + (KR), q8, ka0, ka1, ci, kf0, kf1); __builtin_amdgcn_sched_barrier(0); \
    DMAK8(sk ? t_ + 3 : NT - 1, sk ? (VR) : 8 * TB); DMAV8(sv ? t_ + 1 : NT - 1, sv ? (KN) : 5 * TB);     \
    __builtin_amdgcn_sched_barrier(0); pv8(o, V_lds + (VR), P8, va, ls, ones); \
    WAITV8(2); \
    __builtin_amdgcn_s_setprio(0); BAR8(); \
    WB8(p0, p1, t_); softmax8<false>(p0, p1, ci, ls, o, P8); KPRE8(KN); BAR8(); } while (0)
  int t = 1;
  for (; t + 3 < NT; t += 4) { STEP8(t, TB, 0, 2 * TB); STEP8(t + 1, 2 * TB, TB, 3 * TB); STEP8(t + 2, 3 * TB, 2 * TB, 0); STEP8(t + 3, 0, 3 * TB, TB); }
  const int rem = NT - t;
  if (rem >= 1) STEP8(t, TB, 0, 2 * TB);
  if (rem >= 2) STEP8(t + 1, 2 * TB, TB, 3 * TB);
  if (rem >= 3) STEP8(t + 2, 3 * TB, 2 * TB, 0);
  if (rem == 0) pv8(o, V_lds, P8, va, ls, ones); else if (rem == 1) pv8(o, V_lds + TB, P8, va, ls, ones); else if (rem == 2) pv8(o, V_lds + 2 * TB, P8, va, ls, ones); else pv8(o, V_lds + 3 * TB, P8, va, ls, ones);
  WAITV8(0); BAR8();
  if (!late) BAR8();
#undef STEP8
#undef KPRE8
#undef DMAK8
#undef DMAV8
#undef WAITV8
#undef BAR8
  { const float rl = __builtin_amdgcn_rcpf(ls[0]) * (float)(1 << (L_Y + L_QK));
    const int t2 = tid_fresh(); unsigned char* Ow = Ob + (unsigned)(((t2 >> 6) * 32 + (t2 & 31)) * DM + 4 * ((t2 >> 5) & 1));
#pragma unroll
    for (int d0 = 0; d0 < 4; ++d0)
#pragma unroll
      for (int g = 0; g < 4; ++g) *(unsigned*)(Ow + d0 * 32 + 8 * g) = pk4_fp8(o[d0][4 * g] * rl, o[d0][4 * g + 1] * rl, o[d0][4 * g + 2] * rl, o[d0][4 * g + 3] * rl); }
#undef WB8
}
#undef CAT8
}

#define XB_TMO      128
#define XB_XCNT(j)  (256  + 64 * (j))
#define XB_XSUB(j)  (1280 + 64 * (j))
#define XB_XGEN(j)  (2304 + 64 * (j))
#define XB_TOP      3328
#define XB_TOPGEN   3392
#define XCD_BAR_WORDS 3456
#define XB_SPIN_CAP (1u << 18)
__device__ __forceinline__ unsigned xb_ld(unsigned* p)              { return __hip_atomic_load(p, __ATOMIC_RELAXED, __HIP_MEMORY_SCOPE_AGENT); }
__device__ __forceinline__ unsigned xb_add(unsigned* p, unsigned v) { return __hip_atomic_fetch_add(p, v, __ATOMIC_RELAXED, __HIP_MEMORY_SCOPE_AGENT); }
__device__ __forceinline__ unsigned xb_xcc_id() { return (unsigned)__builtin_amdgcn_s_getreg((3 << 11) | 20) & 0xFu; }
#define XB_SPIN(cond, bar) do { unsigned _sp = 0; while (cond) { __builtin_amdgcn_s_sleep(1); \
    if ((++_sp & 255u) == 0u) { if (xb_ld(&(bar)[XB_TMO])) break; if (_sp > XB_SPIN_CAP) { atomicAdd(&(bar)[XB_TMO], 1u); break; } } } } while (0)
struct XcdBarrier { unsigned* bar; unsigned x; volatile LAS unsigned* st; };
__device__ __forceinline__ XcdBarrier xcd_barrier_post(unsigned* bar, volatile LAS unsigned* st) {
    XcdBarrier b; b.bar = bar; b.x = xb_xcc_id(); b.st = st;
    if (threadIdx.x == 0) (void)xb_add(&bar[XB_XCNT(b.x)], 1u);
    return b;
}
__device__ __forceinline__ void xcd_barrier_complete(unsigned* bar, unsigned x, unsigned& nloc, unsigned& nx) {
    const unsigned G = gridDim.x * gridDim.y * gridDim.z;
    unsigned sum, cnt, mine, sp = 0u;
    for (;;) {
        sum = 0u; cnt = 0u; mine = 0u;
#pragma unroll
        for (unsigned j = 0; j < 16; ++j) { const unsigned c = xb_ld(&bar[XB_XCNT(j)]); sum += c; cnt += (c > 0u) ? 1u : 0u; mine = (j == x) ? c : mine; }
        if (sum == G) break;
        __builtin_amdgcn_s_sleep(1);
        if ((++sp & 255u) == 0u) { if (xb_ld(&bar[XB_TMO])) break; if (sp > XB_SPIN_CAP) { atomicAdd(&bar[XB_TMO], 1u); break; } }
    }
    nloc = mine > 0u ? mine : 1u; nx = cnt > 0u ? cnt : 1u;
}
__device__ __forceinline__ void xcd_barrier(const XcdBarrier& b) {
    asm volatile("s_waitcnt vmcnt(0)" ::: "memory");
    __syncthreads();
    if (threadIdx.x == 0) {
        unsigned* bar = b.bar;
        __builtin_amdgcn_s_waitcnt(0);
        unsigned nloc = b.st[0], nx = b.st[1];
        if (nloc == 0u) { xcd_barrier_complete(bar, b.x, nloc, nx); b.st[0] = nloc; b.st[1] = nx; }
        const unsigned old = xb_add(&bar[XB_XSUB(b.x)], 1u);
        const unsigned gen = old / nloc;
        if (old + 1u == (gen + 1u) * nloc) {
            __builtin_amdgcn_fence(__ATOMIC_RELEASE, "agent");
            asm volatile("s_waitcnt vmcnt(0)" ::: "memory");
            const unsigned og = xb_add(&bar[XB_TOP], 1u);
            const unsigned tg = og / nx;
            if (og + 1u == (tg + 1u) * nx) xb_add(&bar[XB_TOPGEN], 1u);
            else XB_SPIN(xb_ld(&bar[XB_TOPGEN]) == tg, bar);
            __builtin_amdgcn_fence(__ATOMIC_ACQUIRE, "agent");
            xb_add(&bar[XB_XGEN(b.x)], 1u);
            asm volatile("s_waitcnt vmcnt(0)" ::: "memory");
        } else {
            XB_SPIN(xb_ld(&bar[XB_XGEN(b.x)]) == gen, bar);
            __builtin_amdgcn_fence(__ATOMIC_ACQUIRE, "agent");
            asm volatile("s_waitcnt vmcnt(0)" ::: "memory");
        }
    }
    __syncthreads();
}

struct Args { const float* in[20]; float* out; unsigned char* ws; int ph_lo, ph_hi; };
struct Frame {
    LAS unsigned char* lds;
    int tid, lane, wave, vcu, G;
    const float *xp, *xs, *cp, *cs, *w_ada, *b_ada, *w_in, *qn, *kn, *sink, *wbra, *wbrb, *wo, *ln1g, *ln1b, *wg, *wu, *wd, *ln2g, *ln2b;
    float* out; float* mod; float* rope; float* rsc; float* csc; unsigned* cmax;
    bf16 *Win_t, *Wbr_t, *Wo_t, *Wgu_t, *Wd_t, *H, *Y, *P;
    unsigned char *QA8, *KA8, *VT8, *QB8, *KB8, *VTB8;
};
typedef const __attribute__((address_space(4))) Args* KArgs;
__device__ __forceinline__ void frame_ptrs(Frame& F) {
    unsigned long long kp = (unsigned long long)__builtin_amdgcn_kernarg_segment_ptr(); asm volatile("" : "+s"(kp));
    KArgs a = (KArgs)kp; unsigned char* ws = a->ws;
    F.tid = tid_fresh(); F.lane = F.tid & 63; F.wave = __builtin_amdgcn_readfirstlane(F.tid >> 6);
    F.xp = a->in[0]; F.xs = a->in[1]; F.cp = a->in[2]; F.cs = a->in[3]; F.w_ada = a->in[4]; F.b_ada = a->in[5]; F.w_in = a->in[6]; F.qn = a->in[7]; F.kn = a->in[8]; F.sink = a->in[9];
    F.wbra = a->in[10]; F.wbrb = a->in[11]; F.wo = a->in[12]; F.ln1g = a->in[13]; F.ln1b = a->in[14]; F.wg = a->in[15]; F.wu = a->in[16]; F.wd = a->in[17]; F.ln2g = a->in[18]; F.ln2b = a->in[19];
    F.out = a->out; F.mod = (float*)(ws + WS_MOD); F.rope = (float*)(ws + WS_ROPE); F.rsc = (float*)(ws + WS_RSC); F.csc = (float*)(ws + WS_CSC); F.cmax = (unsigned*)(ws + WS_CTL) + CW_CMAX;
    F.Win_t = (bf16*)(ws + WS_WIN); F.Wbr_t = (bf16*)(ws + WS_WBR); F.Wo_t = (bf16*)(ws + WS_WO); F.Wgu_t = (bf16*)(ws + WS_WGU); F.Wd_t = (bf16*)(ws + WS_WD);
    F.H = (bf16*)(ws + WS_H); F.Y = (bf16*)(ws + WS_Y); F.P = (bf16*)(ws + WS_P);
    F.QA8 = ws + WS_QA8; F.KA8 = ws + WS_KA8; F.VT8 = ws + WS_VT8; F.QB8 = ws + WS_QB8; F.KB8 = ws + WS_KB8; F.VTB8 = ws + WS_VTB8;
}
__device__ __forceinline__ float wave_sum(float v) {
#pragma unroll
    for (int o = 1; o < 64; o <<= 1) v += __shfl_xor(v, o);
    return v;
}
__device__ __forceinline__ void p0_transpose_tile(const float* W, int N, int k0, int n0, bf16* WT, int dst_row0, int dst_k0, int ldk, LAS float* scr, int lane) {
    { f32x4 t_[8]; const int c4 = 4 * (lane & 7);
#pragma unroll
      for (int i = 0; i < 8; ++i) t_[i] = __builtin_nontemporal_load((const f32x4*)(W + (size_t)(k0 + 8 * i + (lane >> 3)) * N + n0 + c4));
#pragma unroll
      for (int i = 0; i < 8; ++i) { LAS float* d_ = scr + (8 * i + (lane >> 3)) * 33 + c4; d_[0] = t_[i][0]; d_[1] = t_[i][1]; d_[2] = t_[i][2]; d_[3] = t_[i][3]; } }
    LDS_WAIT(); asm volatile("" ::: "memory");
    const int c = lane & 7;
#pragma unroll
    for (int j = 0; j < 4; ++j) { const int n = (lane >> 3) + 8 * j; const LAS float* s = scr + (8 * c) * 33 + n;
        v4u o; o.x = cvt_pk_bf16(s[0 * 33], s[1 * 33]); o.y = cvt_pk_bf16(s[2 * 33], s[3 * 33]); o.z = cvt_pk_bf16(s[4 * 33], s[5 * 33]); o.w = cvt_pk_bf16(s[6 * 33], s[7 * 33]);
        *(GAS v4u*)(WT + (size_t)(dst_row0 + n) * ldk + dst_k0 + 8 * c) = o; }
    LDS_WAIT(); asm volatile("" ::: "memory");
}
template <bool QKP>
__device__ __forceinline__ void p0_transpose_tile_f8(const float* W, int N, int k0, int n0, unsigned char* WT, int dst_row0, int dst_k0, int ldk, float sc, LAS float* scr, int lane) {
    { f32x4 t_[8]; const int c4 = 4 * (lane & 7);
#pragma unroll
      for (int i = 0; i < 8; ++i) t_[i] = __builtin_nontemporal_load((const f32x4*)(W + (size_t)(k0 + 8 * i + (lane >> 3)) * N + n0 + c4));
#pragma unroll
      for (int i = 0; i < 8; ++i) { LAS float* d_ = scr + (8 * i + (lane >> 3)) * 33 + c4; d_[0] = t_[i][0]; d_[1] = t_[i][1]; d_[2] = t_[i][2]; d_[3] = t_[i][3]; } }
    LDS_WAIT(); asm volatile("" ::: "memory");
    const int c = lane & 7;
#pragma unroll
    for (int j = 0; j < 4; ++j) { const int n = (lane >> 3) + 8 * j; const LAS float* s = scr + (8 * c) * 33 + n;
        v2u o; o.x = pk4_fp8(s[0 * 33] * sc, s[1 * 33] * sc, s[2 * 33] * sc, s[3 * 33] * sc); o.y = pk4_fp8(s[4 * 33] * sc, s[5 * 33] * sc, s[6 * 33] * sc, s[7 * 33] * sc);
        const int t_ = (n0 >> 5) & 3; const int row = QKP ? (n0 & ~127) + 64 * (t_ >> 1) + 32 * (n >> 4) + 8 * ((n >> 2) & 3) + 4 * (t_ & 1) + (n & 3) : dst_row0 + n;
        *(GAS v2u*)(WT + (size_t)row * ldk + dst_k0 + 8 * c) = o; }
    LDS_WAIT(); asm volatile("" ::: "memory");
}
__device__ __forceinline__ void p0_transpose_tile_i8(const float* W, int N, int k0, int n0, unsigned char* WT, int dst_row0, int dst_k0, int ldk, const unsigned* cm, LAS float* scr, int lane) {
    { f32x4 t_[8]; const int c4 = 4 * (lane & 7);
#pragma unroll
      for (int i = 0; i < 8; ++i) t_[i] = __builtin_nontemporal_load((const f32x4*)(W + (size_t)(k0 + 8 * i + (lane >> 3)) * N + n0 + c4));
#pragma unroll
      for (int i = 0; i < 8; ++i) { LAS float* d_ = scr + (8 * i + (lane >> 3)) * 33 + c4; d_[0] = t_[i][0]; d_[1] = t_[i][1]; d_[2] = t_[i][2]; d_[3] = t_[i][3]; } }
    LDS_WAIT(); asm volatile("" ::: "memory");
    const int c = lane & 7;
#pragma unroll
    for (int j = 0; j < 4; ++j) { const int n = (lane >> 3) + 8 * j; const LAS float* s = scr + (8 * c) * 33 + n;
        const float mx = __uint_as_float(cm[dst_row0 + n]); const float inv = mx > 0.f ? 127.0f / mx : 0.f; int q[8];
#pragma unroll
        for (int e = 0; e < 8; ++e) q[e] = (int)__builtin_rintf(s[e * 33] * inv) & 0xff;
        v2u o; o.x = (unsigned)(q[0] | (q[1] << 8) | (q[2] << 16) | (q[3] << 24)); o.y = (unsigned)(q[4] | (q[5] << 8) | (q[6] << 16) | (q[7] << 24));
        *(GAS v2u*)(WT + (size_t)(dst_row0 + n) * ldk + dst_k0 + 8 * c) = o; }
    LDS_WAIT(); asm volatile("" ::: "memory");
}
__device__ __forceinline__ void sincos_poly(double y, double& s, double& c) {
    const double y2 = y * y; double ts = y, tc = 1.0; s = y; c = 1.0;
#pragma unroll
    for (int n = 1; n <= 15; ++n) { tc *= -y2 * (1.0 / (double)((2 * n - 1) * (2 * n))); c += tc; ts *= -y2 * (1.0 / (double)((2 * n) * (2 * n + 1))); s += ts; }
}

__device__ __forceinline__ void phase0(Frame& F) {
    LAS float* sc = (LAS float*)F.lds;
    LAS float* part = (LAS float*)(F.lds + 81920);
    for (int i = F.tid; i < NBATCH * DM; i += NWAVES * 64) { const float c = i < DM ? F.cp[i] : F.cs[i - DM]; sc[i] = c * sigmoidf_(c); }
    __syncthreads();
    for (int cb = F.vcu; cb < (NMOD * DM) / 96; cb += F.G) {
        if (F.tid < 504) { const int ct = F.tid % 24, kg = F.tid / 24; const float* wp = F.w_ada + (size_t)cb * 96 + 4 * ct;
            f32x4 a0 = {0, 0, 0, 0}, a1 = a0, a2 = a0, a3 = a0, a4 = a0;
#pragma unroll 4
            for (int k = kg; k < DM; k += 21) { const f32x4 wv = *(const f32x4*)(wp + (size_t)k * (NMOD * DM));
                a0 += wv * sc[k]; a1 += wv * sc[DM + k]; a2 += wv * sc[2 * DM + k]; a3 += wv * sc[3 * DM + k]; a4 += wv * sc[4 * DM + k]; }
            LAS f32x4* pp = (LAS f32x4*)(part + (kg * 24 + ct) * 20); pp[0] = a0; pp[1] = a1; pp[2] = a2; pp[3] = a3; pp[4] = a4; }
        __syncthreads();
        if (F.tid < 480) { const int b = F.tid / 96, j = F.tid % 96, ct = j >> 2, e = j & 3; float s = F.b_ada[cb * 96 + j];
            for (int kg = 0; kg < 21; ++kg) s += part[(kg * 24 + ct) * 20 + b * 4 + e];
            F.mod[(size_t)b * NMOD * DM + cb * 96 + j] = s; }
        __syncthreads();
    }
    { const int gt = F.vcu * NWAVES * 64 + F.tid;
      if (gt < 6144) { const int isc = gt >= 4096, idx = isc ? gt - 4096 : gt, pos = idx >> 5, i = idx & 31;
          double inv = 1.0; for (int k = 0; k < i; ++k) inv *= 0.7498942093324559;
          const double ang = (double)pos * inv; const double kq = __builtin_rint(ang * 0.15915494309189535); const double y = ang - kq * 6.283185307179586;
          double s, c; sincos_poly(y, s, c);
          float* cosp = F.rope + (isc ? 8192 : 0); float* sinp = cosp + (isc ? 2048 : 4096);
          cosp[idx] = (float)c; sinp[idx] = (float)s; } }
    LAS float* scr = (LAS float*)(F.lds + F.wave * 16384);
    const int gw = F.vcu * NWAVES + F.wave, NGW = F.G * NWAVES;
    constexpr int I_IN = (DM / 64) * (IN_W / 32);
    for (int it = gw; it < I_IN; it += NGW) { const int nb = IN_W / 32, kb = it / nb, n0 = 32 * (it % nb);
        if (n0 < C_VA) p0_transpose_tile_f8<true>(F.w_in, IN_W, 64 * kb, n0, (unsigned char*)F.Win_t, n0, 64 * kb, DM, (float)(1 << L_WIN), scr, F.lane);
        else p0_transpose_tile_f8<false>(F.w_in, IN_W, 64 * kb, n0, (unsigned char*)F.Win_t, n0, 64 * kb, DM, (float)(1 << L_WIN), scr, F.lane); }
}
__device__ __forceinline__ void side2(Frame& F) {
    LAS float* scr = (LAS float*)(F.lds + F.wave * 16384);
    const int gw = F.vcu * NWAVES + F.wave, NGW = F.G * NWAVES;
    constexpr int I_BR = (2048 / 64) * (DM / 32), I_O = (DM / 64) * (DM / 32), I_D = (DFF / 64) * (DM / 32);
    constexpr int NITEMS = 2 * I_BR + I_O + I_D;
    for (int it = gw; it < NITEMS; it += NGW) {
        int r = it;
        if (r < I_BR) { const int nb = DM / 32, kb = r / nb, n0 = 32 * (r % nb); p0_transpose_tile_f8<false>(F.wbra, DM, 64 * kb, n0, (unsigned char*)F.Wbr_t, n0, 64 * kb, DM, (float)(1 << L_WBR), scr, F.lane); continue; } r -= I_BR;
        if (r < I_BR) { const int nb = DM / 32, kb = r / nb, n0 = 32 * (r % nb); p0_transpose_tile_f8<false>(F.wbrb, DM, 64 * kb, n0, (unsigned char*)F.Wbr_t, n0, 2048 + 64 * kb, DM, (float)(1 << L_WBR), scr, F.lane); continue; } r -= I_BR;
        if (r < I_O) { const int nb = DM / 32, kb = r / nb, n0 = 32 * (r % nb); p0_transpose_tile_f8<false>(F.wo, DM, 64 * kb, n0, (unsigned char*)F.Wo_t, n0, 64 * kb, DM, (float)(1 << L_WO), scr, F.lane); continue; } r -= I_O;
        { const int nb = DM / 32, kb = r / nb, n0 = 32 * (r % nb); p0_transpose_tile(F.wd, DM, 64 * kb, n0, F.Wd_t, n0, 64 * kb, DFF, scr, F.lane); }
    }
    for (int it = gw; it < 2 * 16 * 43; it += NGW) { const int mat = it / (16 * 43), r = it % (16 * 43), ks = r / 43, cb = r % 43; const int c = cb * 256 + 4 * F.lane;
        const float* wp = (mat ? F.wu : F.wg) + (size_t)(ks * 256) * DFF + c; f32x4 mx = {0.f, 0.f, 0.f, 0.f};
#pragma unroll 8
        for (int k = 0; k < 256; ++k) { const f32x4 wv = __builtin_nontemporal_load((const f32x4*)(wp + (size_t)k * DFF)); mx = __builtin_elementwise_max(mx, __builtin_elementwise_abs(wv)); }
        unsigned* cm = F.cmax + 256 * (c >> 7) + (mat ? 128 : 0) + (c & 127);
#pragma unroll
        for (int e = 0; e < 4; ++e) atomicMax(cm + e, __float_as_uint(mx[e])); }
}
__device__ __forceinline__ void side4(Frame& F) {
    LAS float* scr = (LAS float*)(F.lds + F.wave * 16384);
    const int gw = F.vcu * NWAVES + F.wave, NGW = F.G * NWAVES;
    constexpr int I_G = (DM / 64) * (DFF / 32);
    for (int it = gw; it < 2 * I_G; it += NGW) { const int mat = it >= I_G, r = mat ? it - I_G : it; const int nb = DFF / 32, kb = r / nb, n0 = 32 * (r % nb);
        p0_transpose_tile_i8(mat ? F.wu : F.wg, DFF, 64 * kb, n0, (unsigned char*)F.Wgu_t, 256 * (n0 >> 7) + (mat ? 128 : 0) + (n0 & 127), 64 * kb, DM, F.cmax, scr, F.lane); }
    for (int i = F.vcu * NWAVES * 64 + F.tid; i < 2 * DFF; i += F.G * NWAVES * 64) F.csc[i] = __uint_as_float(F.cmax[i]) * (1.0f / 127.0f);
}
__device__ __forceinline__ void row_stats(const f32x4 (&v)[16], float& mean, float& rstd) {
    float s = 0.f;
#pragma unroll
    for (int j = 0; j < 16; ++j) s += (v[j].x + v[j].y) + (v[j].z + v[j].w);
    mean = wave_sum(s) * (1.f / DM); float s2 = 0.f;
#pragma unroll
    for (int j = 0; j < 16; ++j) { const f32x4 d = v[j] - mean; s2 += (d.x * d.x + d.y * d.y) + (d.z * d.z + d.w * d.w); }
    rstd = 1.f / sqrtf(wave_sum(s2) * (1.f / DM) + LN_EPS);
}
__device__ __forceinline__ int row_batch(int m) { return m < SEQ_P ? 0 : 1 + ((m - SEQ_P) >> 12); }
__device__ __forceinline__ f32x4 ldg4(const float* base, unsigned off) { return *(const GAS f32x4*)((const GAS char*)base + off); }
__device__ __forceinline__ void stg4(float* base, unsigned off, f32x4 v) { *(GAS f32x4*)((GAS char*)base + off) = v; }
__device__ __forceinline__ void stg1(void* base, unsigned off, unsigned v) { *(GAS unsigned*)((GAS char*)base + off) = v; }
__device__ __forceinline__ void phase1(Frame& F) {
    const int gw = F.vcu * NWAVES + F.wave, NGW = F.G * NWAVES; const unsigned lo = (unsigned)F.lane * 16u;
    for (int m = gw; m < M; m += NGW) {
        const float* xrow = m < SEQ_P ? F.xp + (size_t)m * DM : F.xs + (size_t)(m - SEQ_P) * DM;
        const float* md = F.mod + (size_t)row_batch(m) * NMOD * DM;
        f32x4 v[16];
#pragma unroll
        for (int j = 0; j < 16; ++j) v[j] = ldg4(xrow, lo + 1024u * j);
        float mean, rstd; row_stats(v, mean, rstd);
        unsigned char* orow = (unsigned char*)F.H + (size_t)m * DM; constexpr float SC = (float)(1 << L_H1);
#pragma unroll
        for (int j = 0; j < 16; ++j) { const f32x4 sh = ldg4(md, lo + 1024u * j), scl = ldg4(md + DM, lo + 1024u * j);
            const f32x4 y = ((v[j] - mean) * rstd * (scl + 1.0f) + sh) * SC; stg1(orow, (unsigned)F.lane * 4u + 256u * j, pk4_fp8(y.x, y.y, y.z, y.w)); }
    }
}
__device__ __forceinline__ void phase4(Frame& F, char* lds) {
    for (int idx = F.vcu; idx < 1536; idx += F.G) {
        const bool pr = idx < 512; const int u = pr ? idx : idx - 512;
        const int head = pr ? u >> 5 : (u >> 4) & 15, qb = pr ? u & 31 : u & 15; const size_t row0 = pr ? 0 : SEQ_P + (size_t)(u >> 8) * SEQ_S;
        att8::attn_a8<0>(F.QA8 + (row0 + qb * 256) * 2048 + head * HD, F.KA8 + row0 * 512 + (head >> 2) * HD, F.VT8 + ((row0 >> 6) * 4 + (head >> 2)) * (size_t)att8::TB,
            (unsigned char*)F.Y + (row0 + qb * 256) * DM + head * HD, pr ? SEQ_P / 64 : SEQ_S / 64, lds, 0, 0.f, 0.f); }
    for (int u = F.vcu; u < 1536; u += F.G) { const int pm = u >> 4, head = u & 15;
        const int T = pm < 32 ? SEQ_P : SEQ_S, qb = pm < 32 ? pm : (pm - 32) & 15; const size_t row0 = pm < 32 ? 0 : SEQ_P + (size_t)((pm - 32) >> 4) * SEQ_S;
        const int q0 = qb * 256, ks = q0 >= 128 ? q0 - 128 : 0, ke = q0 + 384 <= T ? q0 + 384 : T;
        const float slope = __builtin_amdgcn_exp2f(-0.5f * (float)(head + 1));
        const size_t kr0 = row0 + ks; att8::attn_a8<1>(F.QB8 + (row0 + q0) * 2048 + head * HD, F.KB8 + kr0 * 512 + (head >> 2) * HD, F.VTB8 + ((kr0 >> 6) * 4 + (head >> 2)) * (size_t)att8::TB,
            (unsigned char*)F.Y + (row0 + q0) * DM + 2048 + head * HD, (ke - ks) / 64, lds, q0 - ks, slope * 1.4426950408889634f, F.sink[head] * 1.4426950408889634f); }
}
__device__ __forceinline__ void ld_row_h(const unsigned short* row, unsigned lane, f32x4 (&v)[16]) {
#pragma unroll
    for (int j = 0; j < 8; ++j) { const v4u hv = *(const GAS v4u*)((const GAS char*)row + lane * 16u + 1024u * j);
        v[2 * j] = (f32x4){h_lo(hv.x), h_hi(hv.x), h_lo(hv.y), h_hi(hv.y)}; v[2 * j + 1] = (f32x4){h_lo(hv.z), h_hi(hv.z), h_lo(hv.w), h_hi(hv.w)}; }
}
__device__ __forceinline__ void phase7(Frame& F) {
    const int gw = F.vcu * NWAVES + F.wave, NGW = F.G * NWAVES; const unsigned ln = (unsigned)F.lane, lo = ln * 32u;
    for (int m = gw; m < M; m += NGW) {
        const float* md = F.mod + (size_t)row_batch(m) * NMOD * DM;
        f32x4 v[16]; ld_row_h((const unsigned short*)F.P + (size_t)m * DM, ln, v);
        float mean, rstd; row_stats(v, mean, rstd);
        unsigned short* xrow = (unsigned short*)F.H + (size_t)m * DM;
#pragma unroll
        for (int j = 0; j < 8; ++j) {
#pragma unroll
            for (int h = 0; h < 2; ++h) { const f32x4 g = ldg4(F.ln1g, lo + 2048u * j + 16u * h), b = ldg4(F.ln1b, lo + 2048u * j + 16u * h); v[2 * j + h] = (v[2 * j + h] - mean) * rstd * g + b; }
            v4u w; w.x = pk_h2(v[2 * j].x, v[2 * j].y); w.y = pk_h2(v[2 * j].z, v[2 * j].w); w.z = pk_h2(v[2 * j + 1].x, v[2 * j + 1].y); w.w = pk_h2(v[2 * j + 1].z, v[2 * j + 1].w);
            *(GAS v4u*)((GAS char*)xrow + ln * 16u + 1024u * j) = w;
            v[2 * j] = (f32x4){h_lo(w.x), h_hi(w.x), h_lo(w.y), h_hi(w.y)}; v[2 * j + 1] = (f32x4){h_lo(w.z), h_hi(w.z), h_lo(w.w), h_hi(w.w)}; }
        row_stats(v, mean, rstd);
        float amax = 0.f;
#pragma unroll
        for (int j = 0; j < 16; ++j) { const f32x4 sh = ldg4(md + 3 * DM, lo + 2048u * (j >> 1) + 16u * (j & 1)), scl = ldg4(md + 4 * DM, lo + 2048u * (j >> 1) + 16u * (j & 1));
            v[j] = (v[j] - mean) * rstd * (scl + 1.0f) + sh; amax = fmaxf(amax, fmaxf(fmaxf(fabsf(v[j].x), fabsf(v[j].y)), fmaxf(fabsf(v[j].z), fabsf(v[j].w)))); }
#pragma unroll
        for (int o = 1; o < 64; o <<= 1) amax = fmaxf(amax, __shfl_xor(amax, o));
        const float inv = amax > 0.f ? 127.0f / amax : 0.f;
        if (F.lane == 0) F.rsc[m] = amax * (1.0f / 127.0f);
        unsigned char* orow = (unsigned char*)F.Y + (size_t)m * DM;
#pragma unroll
        for (int j = 0; j < 8; ++j) { unsigned q[2];
#pragma unroll
            for (int h = 0; h < 2; ++h) { const f32x4 y = v[2 * j + h]; const int q0 = (int)__builtin_rintf(y.x * inv) & 0xff, q1 = (int)__builtin_rintf(y.y * inv) & 0xff, q2 = (int)__builtin_rintf(y.z * inv) & 0xff, q3 = (int)__builtin_rintf(y.w * inv) & 0xff;
                q[h] = (unsigned)(q0 | (q1 << 8) | (q2 << 16) | (q3 << 24)); }
            *(GAS v2u*)((GAS char*)orow + ln * 8u + 512u * j) = (v2u){q[0], q[1]}; }
    }
}
__device__ __forceinline__ void phase10(Frame& F) {
    const int gw = F.vcu * NWAVES + F.wave, NGW = F.G * NWAVES; const unsigned ln = (unsigned)F.lane, lo = ln * 32u;
    for (int m = gw; m < M; m += NGW) {
        f32x4 v[16]; ld_row_h((const unsigned short*)F.H + (size_t)m * DM, ln, v);
        float mean, rstd; row_stats(v, mean, rstd);
        float* orow = F.out + (size_t)m * DM;
#pragma unroll
        for (int j = 0; j < 16; ++j) { const unsigned off = lo + 2048u * (j >> 1) + 16u * (j & 1); const f32x4 g = ldg4(F.ln2g, off), b = ldg4(F.ln2b, off); stg4(orow, off, (v[j] - mean) * rstd * g + b); }
    }
}

__global__ void __launch_bounds__(NWAVES * 64, 2) enc_fwd(Args args) {
    extern __shared__ __attribute__((aligned(16))) unsigned char lds[];
    Frame F;
    F.lds = (LAS unsigned char*)lds;
    F.tid = threadIdx.x; F.lane = F.tid & 63; F.wave = __builtin_amdgcn_readfirstlane(F.tid >> 6);
    F.G = gridDim.x; { const int bx = blockIdx.x; F.vcu = (F.G % 8 == 0) ? (bx % 8) * (F.G / 8) + bx / 8 : bx; }
    gu32* ctl = (gu32*)(args.ws + WS_CTL);
    volatile LAS unsigned* MISC = (volatile LAS unsigned*)(F.lds + MISC_OFF);
    for (int u = F.tid; u < (LDS_BYTES - LDSCTL_OFF) / 4; u += NWAVES * 64) ((LAS unsigned*)(F.lds + LDSCTL_OFF))[u] = 0u;
    __syncthreads();
    XcdBarrier bar; bar.bar = (unsigned*)(ctl + CW_BAR); bar.x = 0; bar.st = nullptr;
    if (N_LAUNCHES == 1) bar = xcd_barrier_post((unsigned*)(ctl + CW_BAR), MISC + 8);
    const int lo = args.ph_lo, hi = args.ph_hi;
#ifndef PH_MASK
#define PH_MASK 0x7ff
#endif
#define IN(k) (((PH_MASK >> (k)) & 1) && lo <= (k) && (k) < hi)
#define SEAM(k) do { if (IN(k) && IN((k) + 1)) xcd_barrier(bar); } while (0)
#ifndef REP_PHASE
#define REP_PHASE -1
#endif
#define REPS(k) ((k) == REP_PHASE ? 2 : 1)
    if (IN(0)) for (int rep = 0; rep < REPS(0); ++rep) { if (rep) xcd_barrier(bar); frame_ptrs(F); phase0(F); } SEAM(0);
    if (IN(1)) for (int rep = 0; rep < REPS(1); ++rep) { if (rep) xcd_barrier(bar); frame_ptrs(F); phase1(F); } SEAM(1);
    if (IN(2)) for (int rep = 0; rep < REPS(2); ++rep) { if (rep) xcd_barrier(bar); frame_ptrs(F); if ((F.vcu & 1) == 0) { side2(F); __syncthreads(); frame_ptrs(F); } pg8::Gemm g{F.H, F.Win_t, DM, DM, DM, 0, e8m0x4(L_H1), e8m0x4(L_WIN)}; pg8::EpiProj E{F.P, F.qn, F.kn, F.rope, (LAS float*)(F.lds + LDSCTL_OFF + 1024), F.QA8, F.KA8, F.VT8, F.QB8, F.KB8, F.VTB8};
#if defined(KDOUBLE_PHASE) && KDOUBLE_PHASE == 2
        pg8::PairedOrder S; S.init(M, IN_W, F.G, (int)blockIdx.x); pg8::EpiHalf<pg8::EpiProj, false> E2{E}; pg8::gemm_phase<pg8::EpiHalf<pg8::EpiProj, false>, pg8::PairedOrder, 1>(F.lds, g, S, E2); }
#else
        pg8::StaticOrder S; S.init(M, IN_W, F.G, (int)blockIdx.x); pg8::gemm_phase<pg8::EpiProj, pg8::StaticOrder, 1>(F.lds, g, S, E); }
#endif
        if (IN(2) && (F.vcu & 1)) { frame_ptrs(F); side2(F); }
        SEAM(2);
    if (IN(4)) for (int rep = 0; rep < REPS(4); ++rep) { if (rep) xcd_barrier(bar); frame_ptrs(F); if ((F.vcu & 1) == 0) { side4(F); __syncthreads(); frame_ptrs(F); } phase4(F, (char*)lds); __syncthreads(); if (F.vcu & 1) { frame_ptrs(F); side4(F); } } SEAM(4);
    if (IN(5)) for (int rep = 0; rep < REPS(5); ++rep) { if (rep) xcd_barrier(bar); frame_ptrs(F); pg8::Gemm g{F.Y, F.Wbr_t, DM, DM, 2048, 2048, e8m0x4(L_Y), e8m0x4(L_WBR)}; pg8::PairedOrder S; S.init(M, DM, F.G, (int)blockIdx.x); pg8::EpiMerge E{F.P, (unsigned char*)F.H};
        pg8::gemm_phase<pg8::EpiMerge, pg8::PairedOrder, 1>(F.lds, g, S, E); } SEAM(5);
    if (IN(6)) for (int rep = 0; rep < REPS(6); ++rep) { if (rep) xcd_barrier(bar); frame_ptrs(F); pg8::Gemm g{F.H, F.Wo_t, DM, DM, DM, 0, e8m0x4(L_MG), e8m0x4(L_WO)}; pg8::StaticOrder S; S.init(M, DM, F.G, (int)blockIdx.x); pg8::EpiRes<false> E{F.xp, F.xs, nullptr, (unsigned short*)F.P, F.mod + 2 * DM};
        pg8::gemm_phase<pg8::EpiRes<false>, pg8::StaticOrder, 1>(F.lds, g, S, E); } SEAM(6);
    if (IN(7)) { frame_ptrs(F); phase7(F); } SEAM(7);
    if (IN(8)) for (int rep = 0; rep < REPS(8); ++rep) { if (rep) xcd_barrier(bar); frame_ptrs(F); pg8::Gemm g{F.Y, F.Wgu_t, DM, DM, DM, 0, 0, 0}; pg8::EpiSwiglu E{F.P, F.rsc, F.csc};
#if defined(KDOUBLE_PHASE) && KDOUBLE_PHASE == 8
        pg8::PairedOrder S; S.init(M, 2 * DFF, F.G, (int)blockIdx.x); pg8::EpiHalf<pg8::EpiSwiglu, true> E2{E}; pg8::gemm_phase<pg8::EpiHalf<pg8::EpiSwiglu, true>, pg8::PairedOrder, 2>(F.lds, g, S, E2); }
#else
        pg8::StaticOrder S; S.init(M, 2 * DFF, F.G, (int)blockIdx.x); pg8::gemm_phase<pg8::EpiSwiglu, pg8::StaticOrder, 2>(F.lds, g, S, E); }
#endif
        SEAM(8);
    if (IN(9)) { frame_ptrs(F); pg8::Gemm g{F.P, F.Wd_t, 2 * DFF, 2 * DFF, 2 * DFF, 0, 0, 0}; pg8::StaticOrder S; S.init(M, DM, F.G, (int)blockIdx.x, 2); pg8::EpiRes<true> E{nullptr, nullptr, (const unsigned short*)F.H, (unsigned short*)F.H, F.mod + 5 * DM};
        pg8::gemm_phase<pg8::EpiRes<true>, pg8::StaticOrder, 0>(F.lds, g, S, E); } SEAM(9);
    if (IN(10)) { frame_ptrs(F); phase10(F); }
#undef IN
#undef SEAM
}

extern "C" void kernel_launch(void* const* d_in, const int* in_sizes, int n_in, void* d_out, int out_size, void* d_ws, size_t ws_size, hipStream_t stream) {
    static int grid = 0;
    if (grid == 0) {
        if (n_in != 20 || in_sizes[0] != SEQ_P * DM || out_size != M * DM || ws_size < WS_END) {
            fprintf(stderr, "kernel_launch: shape mismatch: n_in %d in0 %d out %d ws %zu (need %zu)\n", n_in, n_in > 0 ? in_sizes[0] : -1, out_size, ws_size, (size_t)WS_END); grid = -1; return; }
        int dev = 0, cus = 0, per_cu = 0;
        if (hipGetDevice(&dev) != hipSuccess || hipDeviceGetAttribute(&cus, hipDeviceAttributeMultiprocessorCount, dev) != hipSuccess) { grid = -1; return; }
        if (hipFuncSetAttribute((const void*)enc_fwd, hipFuncAttributeMaxDynamicSharedMemorySize, LDS_BYTES) != hipSuccess) { fprintf(stderr, "kernel_launch: hipFuncSetAttribute failed\n"); grid = -1; return; }
        if (hipOccupancyMaxActiveBlocksPerMultiprocessor(&per_cu, (const void*)enc_fwd, NWAVES * 64, LDS_BYTES) != hipSuccess || per_cu < 1) { fprintf(stderr, "kernel_launch: occupancy query says %d\n", per_cu); (void)hipGetLastError(); grid = -1; return; }
        grid = cus;
    }
    if (grid < 0) return;
    (void)hipMemsetAsync((char*)d_ws + WS_CTL, 0, CTL_ZERO_BYTES, stream);
    Args a{};
    for (int i = 0; i < 20; ++i) a.in[i] = (const float*)d_in[i];
    a.out = (float*)d_out; a.ws = (unsigned char*)d_ws;
    if (N_LAUNCHES == 1) { a.ph_lo = 0; a.ph_hi = N_PHASES; hipLaunchKernelGGL(enc_fwd, dim3(grid), dim3(NWAVES * 64), LDS_BYTES, stream, a); }
    else for (int li = 0; li < N_PHASES; ++li) { a.ph_lo = li; a.ph_hi = li + 1; hipLaunchKernelGGL(enc_fwd, dim3(grid), dim3(NWAVES * 64), LDS_BYTES, stream, a); }
    const hipError_t le = hipPeekAtLastError();
    if (le != hipSuccess) fprintf(stderr, "kernel_launch: launch failed: %s\n", hipGetErrorName(le));
}
```

```cpp
#include <hip/hip_runtime.h>
#include <hip/hip_bf16.h>
#include <cstdio>
#include <cstdint>

#ifndef MK_N_LAUNCHES
#define MK_N_LAUNCHES 1
#endif
constexpr int N_PHASES = 11;
constexpr int N_LAUNCHES = MK_N_LAUNCHES;
constexpr int NWAVES = 8;

constexpr int DM = 4096, SEQ_P = 8192, SEQ_S = 4096, NB_S = 4, NBATCH = 5;
constexpr int M = SEQ_P + NB_S * SEQ_S;
constexpr int HD = 128, NHA = 16, NKVA = 4, NHB = 16, NKVB = 4;
constexpr int C_QA = 0, C_KA = 2048, C_VA = 2560, C_QB = 3072, C_KB = 5120, C_VB = 5632, C_GA = 6144, C_GB = 10240, IN_W = 14336;
constexpr int DFF = 11008, NMOD = 6;
constexpr int GATE_B0 = C_GA * 2;
constexpr float ALPHA = 1.189207115002721f, LN_EPS = 1e-5f, RMS_EPS = 1e-6f;
constexpr float ATT_SCALE = 0.088388347648318440f;
constexpr int L_H1 = 3, L_WIN = 9, L_Y = 5, L_WBR = 9, L_MG = 6, L_WO = 10, L_QK = 4;
constexpr float Q_PRE = ATT_SCALE * 1.4426950408889634f * 8.f;
constexpr int e8m0x4(int L) { return (127 - L) * 0x01010101; }

constexpr size_t MiB = 1u << 20;
constexpr size_t WS_CTL = 0, CTL_ZERO_BYTES = 1 * MiB;
constexpr size_t WS_MOD = 1 * MiB;
constexpr size_t WS_ROPE = 1 * MiB + 512 * 1024;
constexpr size_t WS_RSC = 1 * MiB + 640 * 1024;
constexpr size_t WS_CSC = 1 * MiB + 768 * 1024;
constexpr int CW_CMAX = 16384;
constexpr size_t WS_WIN = 2 * MiB;
constexpr size_t WS_WBR = WS_WIN + 112 * MiB;
constexpr size_t WS_WO = WS_WBR + 32 * MiB;
constexpr size_t WS_WGU = WS_WO + 32 * MiB;
constexpr size_t WS_WD = WS_WGU + 172 * MiB;
constexpr size_t WS_H = WS_WD + 86 * MiB;
constexpr size_t WS_Y = WS_H + 192 * MiB;
constexpr size_t WS_P = WS_Y + 96 * MiB;
constexpr size_t WS_QA8 = WS_P + 672 * MiB;
constexpr size_t WS_KA8 = WS_QA8 + 48 * MiB;
constexpr size_t WS_VT8 = WS_KA8 + 12 * MiB;
constexpr size_t WS_QB8 = WS_VT8 + 12 * MiB, WS_KB8 = WS_QB8 + 48 * MiB, WS_VTB8 = WS_KB8 + 12 * MiB;
constexpr size_t WS_END = WS_VTB8 + 12 * MiB;
static_assert((size_t)IN_W * DM * 2 <= 112 * MiB && (size_t)2 * DFF * DM * 2 <= 172 * MiB && (size_t)DM * DFF * 2 <= 86 * MiB && (size_t)M * IN_W * 2 <= 672 * MiB, "ws map");
constexpr int CW_TMO = 0, CW_BAR = 4096;

constexpr int RING_BYTES = 131072, LDSCTL_OFF = RING_BYTES, MISC_OFF = LDSCTL_OFF + 320, LDS_BYTES = 147456;

#define GAS __attribute__((address_space(1)))
#define LAS __attribute__((address_space(3)))
typedef unsigned short bf16;
typedef unsigned v4u __attribute__((ext_vector_type(4)));
typedef unsigned v2u __attribute__((ext_vector_type(2)));
typedef float f32x4 __attribute__((ext_vector_type(4)));
typedef float f32x2 __attribute__((ext_vector_type(2)));
typedef float f32x16 __attribute__((ext_vector_type(16)));
typedef short bf16x8 __attribute__((ext_vector_type(8)));
typedef short s16x4 __attribute__((ext_vector_type(4)));
typedef GAS unsigned gu32;
#define RLX_AGENT __ATOMIC_RELAXED, __HIP_MEMORY_SCOPE_AGENT
#define LDS_WAIT() asm volatile("s_waitcnt lgkmcnt(0)" ::: "memory")
#define VM_WAIT() asm volatile("s_waitcnt vmcnt(0)" ::: "memory")
__device__ __forceinline__ unsigned cvt_pk_bf16(float lo, float hi) { unsigned r; asm volatile("v_cvt_pk_bf16_f32 %0, %1, %2" : "=v"(r) : "v"(lo), "v"(hi)); return r; }
__device__ __forceinline__ float clamp448(float x) { return __builtin_amdgcn_fmed3f(x, -448.f, 448.f); }
__device__ __forceinline__ unsigned pk4_fp8(float a, float b, float c, float d) {
    int w = 0; w = __builtin_amdgcn_cvt_pk_fp8_f32(clamp448(a), clamp448(b), w, false); w = __builtin_amdgcn_cvt_pk_fp8_f32(clamp448(c), clamp448(d), w, true); return (unsigned)w; }
typedef _Float16 h16x2 __attribute__((ext_vector_type(2)));
__device__ __forceinline__ unsigned pk_h2(float a, float b) { const h16x2 h = {(_Float16)a, (_Float16)b}; return __builtin_bit_cast(unsigned, h); }
__device__ __forceinline__ float h_lo(unsigned w) { return (float)__builtin_bit_cast(h16x2, w)[0]; }
__device__ __forceinline__ float h_hi(unsigned w) { return (float)__builtin_bit_cast(h16x2, w)[1]; }
__device__ __forceinline__ unsigned pk4_gate(float a, float b, float c, float d) { unsigned w = 0;
    w = __builtin_amdgcn_cvt_pk_u8_f32(a * 256.f - 0.5f, 0, w); w = __builtin_amdgcn_cvt_pk_u8_f32(b * 256.f - 0.5f, 1, w); w = __builtin_amdgcn_cvt_pk_u8_f32(c * 256.f - 0.5f, 2, w); w = __builtin_amdgcn_cvt_pk_u8_f32(d * 256.f - 0.5f, 3, w); return w; }
template <int K> __device__ __forceinline__ float gate_f(unsigned w) { const float q = (float)((w >> (8 * K)) & 0xffu);
    return q * (1.f / 256.f) + (1.f / 512.f); }
__device__ __forceinline__ float bf_lo(unsigned w) { return __uint_as_float(w << 16); }
__device__ __forceinline__ float bf_hi(unsigned w) { return __uint_as_float(w & 0xffff0000u); }
__device__ __forceinline__ float sigmoidf_(float x) { return __builtin_amdgcn_rcpf(1.0f + __builtin_amdgcn_exp2f(-1.4426950408889634f * x)); }

__device__ __forceinline__ int kpos(int kappa) { const int k5 = kappa & 31; return 32 * ((k5 >> 2) & 1) + 16 * (kappa >> 5) + (k5 & 3) + 4 * (k5 >> 3); }
__device__ __forceinline__ int tid_fresh() { int t = threadIdx.x; asm volatile("" : "+v"(t)); return t; }

namespace pg8 {
constexpr int BM = 256, BK = 64, HALF = 128, HTB = HALF * BK * 2, STAGE_BYTES = 8 * HTB, NXCD = 8, WGM = 8;
__host__ __device__ __forceinline__ int lds_byte(int r, int c) { const int st = (r >> 4) * 2 + (c >> 5), rr = r & 15, cc = c & 31, ob = rr * 64 + cc * 2; return st * 1024 + (ob ^ (((ob >> 9) & 1) << 5)); }
__host__ __device__ __forceinline__ void stage_rc(int b, int& R, int& C) { const int st = b / 1024, sb = b % 1024, swz = sb ^ (((sb >> 9) & 1) << 5); R = (st >> 1) * 16 + swz / 64; C = (st & 1) * 32 + (swz % 64) / 2; }
__host__ __device__ __forceinline__ int perm32(int rho) { const int n = rho >> 4, i = rho & 15; return 8 * (i >> 2) + 4 * n + (i & 3); }

struct Unit { int pm, pn, kh; };
struct Gemm { const void* A; const void* Bt; int lda, ldb, kbytes, khoff; int sa, sb; };

struct StaticOrder {
    int nM, nN, nwg, G, c, wgm;
    __device__ void init(int M_, int N_, int G_, int c_, int wgm_ = WGM) { nM = M_ / BM; nN = N_ / BM; nwg = nM * nN; G = G_; c = c_; wgm = wgm_; }
    __device__ bool tile(int i, Unit& u) const {
        const long L = (long)i * G + c; if (L >= nwg) return false;
        int wgid = (int)L; { const int q = nwg / NXCD, r = nwg % NXCD, xcd = wgid % NXCD, off = wgid / NXCD; wgid = (xcd < r ? xcd * (q + 1) : r * (q + 1) + (xcd - r) * q) + off; }
        const int nig = wgm * nN, gid = wgid / nig, fm = gid * wgm, gsz = (nM - fm) < wgm ? (nM - fm) : wgm;
        u.pm = fm + ((wgid % nig) % gsz); u.pn = (wgid % nig) / gsz; u.kh = 0; return true;
    }
    __device__ bool next(int i, Unit& u) const { return tile(i, u); }
};
struct PairedOrder : StaticOrder {
    __device__ bool next(int i, Unit& u) const { const bool ok = tile(i >> 1, u); u.kh = i & 1; return ok; }
};

typedef f32x4 Acc[2][2][4][2];
typedef int v4i __attribute__((ext_vector_type(4)));
typedef int v8i __attribute__((ext_vector_type(8)));

struct EpiProj {
    static constexpr bool PERM = true, PAIRED = false;
    bf16* O; const float* qn; const float* kn; const float* rope; LAS float* xs;
    unsigned char* qa8; unsigned char* ka8; unsigned char* vt8; unsigned char* qb8; unsigned char* kb8; unsigned char* vtb8;
    __device__ __forceinline__ void operator()(const Acc& acc, const Unit& u, int wr, int wc, int fr, int fq) const {
        const int row0 = u.pm * BM + wr * 64 + fr;
        if (u.pn < 10) {
            const int p = wc >> 1, i0 = 16 * (wc & 1) + 4 * fq; const float* gn = (u.pn < 8 ? qn : kn) + 64 * p + i0;
            const f32x4 g1 = *(const f32x4*)gn, g2 = *(const f32x4*)(gn + 32);
#pragma unroll
            for (int ai = 0; ai < 2; ++ai)
#pragma unroll
                for (int m = 0; m < 4; ++m)
#pragma unroll
                    for (int bj = 0; bj < 2; ++bj) { const f32x4 v0 = acc[ai][bj][m][0], v1 = acc[ai][bj][m][1];
                        float ss = (v0[0] * v0[0] + v0[1] * v0[1]) + (v0[2] * v0[2] + v0[3] * v0[3]) + (v1[0] * v1[0] + v1[1] * v1[1]) + (v1[2] * v1[2] + v1[3] * v1[3]);
                        ss += __shfl_xor(ss, 16); ss += __shfl_xor(ss, 32);
                        if (fq == 0) xs[((ai * HALF + wr * 64 + m * 16 + fr) * 2 + bj) * 4 + wc] = ss; }
            asm volatile("s_waitcnt lgkmcnt(0)" ::: "memory"); __builtin_amdgcn_s_barrier(); asm volatile("" ::: "memory");
            const float* tab = rope + (p ? 8192 : 0); const int sin_off = p ? 2048 : 4096;
#pragma unroll
            for (int ai = 0; ai < 2; ++ai)
#pragma unroll
                for (int m = 0; m < 4; ++m) { const int r = row0 + ai * HALF + m * 16; const int t = r < SEQ_P ? r : (r - SEQ_P) & (SEQ_S - 1);
                    const float* tp = tab + (p ? (t & 63) : (t >> 6)) * 32 + i0; const f32x4 cs = *(const f32x4*)tp, sn = *(const f32x4*)(tp + sin_off);
#pragma unroll
                    for (int bj = 0; bj < 2; ++bj) { unsigned char* dst = (u.pn < 8 ? qa8 + (size_t)r * 2048 + (2 * u.pn + bj) * HD : ka8 + (size_t)r * 512 + (2 * (u.pn - 8) + bj) * HD) + 64 * p + i0; const f32x4 q4 = *(const LAS f32x4*)(xs + ((ai * HALF + wr * 64 + m * 16 + fr) * 2 + bj) * 4);
                        const float rs = 1.0f / sqrtf(((q4[0] + q4[1]) + (q4[2] + q4[3])) * (1.0f / HD) + RMS_EPS);
                        const f32x4 x1 = acc[ai][bj][m][0] * rs * g1, x2 = acc[ai][bj][m][1] * rs * g2;
                        const f32x4 y1 = x1 * cs - x2 * sn, y2 = x2 * cs + x1 * sn;
                        const float SC = (float)(1 << L_QK) * (u.pn < 8 ? Q_PRE : 1.0f);
                        *(unsigned*)dst = pk4_fp8(y1[0] * SC, y1[1] * SC, y1[2] * SC, y1[3] * SC); *(unsigned*)(dst + 32) = pk4_fp8(y2[0] * SC, y2[1] * SC, y2[2] * SC, y2[3] * SC); } }
            return;
        }
        if (u.pn == 10 || u.pn == 11 || u.pn == 22 || u.pn == 23) {
            unsigned char* const vt = u.pn < 12 ? vt8 : vtb8; const int h0 = 2 * (u.pn < 12 ? u.pn - 10 : u.pn - 22);
            constexpr float SC = (float)(1 << L_QK);
#pragma unroll
            for (int ai = 0; ai < 2; ++ai)
#pragma unroll
                for (int m = 0; m < 4; ++m) { const int r = row0 + ai * HALF + m * 16; const int gb = r >> 6, pos = kpos(r & 63);
#pragma unroll
                    for (int bj = 0; bj < 2; ++bj) { unsigned char* vb = vt + ((size_t)(gb * 4 + h0 + bj) * HD + wc * 32 + 8 * fq) * 64 + pos;
                        const f32x4 v0 = acc[ai][bj][m][0] * SC, v1 = acc[ai][bj][m][1] * SC; const unsigned w0 = pk4_fp8(v0[0], v0[1], v0[2], v0[3]), w1 = pk4_fp8(v1[0], v1[1], v1[2], v1[3]);
#pragma unroll
                        for (int e = 0; e < 4; ++e) { vb[e * 64] = (unsigned char)(w0 >> (8 * e)); vb[(4 + e) * 64] = (unsigned char)(w1 >> (8 * e)); } } }
            return;
        }
        const int col0 = u.pn * BM + wc * 32 + 8 * fq; const bool sig = u.pn * BM >= C_GA;
        if (!sig) {
            const bool isq = u.pn < 20; const float SC = (float)(1 << L_QK) * (isq ? Q_PRE : 1.0f);
#pragma unroll
            for (int ai = 0; ai < 2; ++ai)
#pragma unroll
                for (int m = 0; m < 4; ++m) { const size_t r = (size_t)(row0 + ai * HALF + m * 16);
                    unsigned char* dst = isq ? qb8 + r * 2048 + (col0 - C_QB) : kb8 + r * 512 + (col0 - C_KB);
#pragma unroll
                    for (int bj = 0; bj < 2; ++bj) { const f32x4 v0 = acc[ai][bj][m][0] * SC, v1 = acc[ai][bj][m][1] * SC;
                        v2u w; w.x = pk4_fp8(v0[0], v0[1], v0[2], v0[3]); w.y = pk4_fp8(v1[0], v1[1], v1[2], v1[3]); *(v2u*)(dst + bj * HALF) = w; } }
            return;
        }
#pragma unroll
        for (int ai = 0; ai < 2; ++ai)
#pragma unroll
            for (int m = 0; m < 4; ++m) { bf16* rowp = O + (size_t)(row0 + ai * HALF + m * 16) * IN_W + col0;
#pragma unroll
                for (int bj = 0; bj < 2; ++bj) { f32x4 v0 = acc[ai][bj][m][0], v1 = acc[ai][bj][m][1];
                    if (sig) {
#pragma unroll
                        for (int e = 0; e < 4; ++e) { v0[e] = sigmoidf_(v0[e]); v1[e] = sigmoidf_(v1[e]); }
                        v2u g; g.x = pk4_gate(v0[0], v0[1], v0[2], v0[3]); g.y = pk4_gate(v1[0], v1[1], v1[2], v1[3]);
                        *(v2u*)((unsigned char*)(rowp - col0) + GATE_B0 + (col0 - C_GA) + bj * HALF) = g; }
                    else { v4u w; w.x = cvt_pk_bf16(v0[0], v0[1]); w.y = cvt_pk_bf16(v0[2], v0[3]); w.z = cvt_pk_bf16(v1[0], v1[1]); w.w = cvt_pk_bf16(v1[2], v1[3]);
                        *(v4u*)(rowp + bj * HALF) = w; } } }
    }
};
struct EpiMerge {
    static constexpr bool PERM = true, PAIRED = true;
    const bf16* P; unsigned char* O;
    __device__ __forceinline__ void mid(Acc& acc, const Unit& u, int wr, int wc, int fr, int fq) const {
        const int row0 = u.pm * BM + wr * 64 + fr, col0 = u.pn * BM + wc * 32 + 8 * fq;
#pragma unroll
        for (int ai = 0; ai < 2; ++ai)
#pragma unroll
            for (int m = 0; m < 4; ++m) { const unsigned char* gp = (const unsigned char*)(P + (size_t)(row0 + ai * HALF + m * 16) * IN_W) + GATE_B0 + col0;
#pragma unroll
                for (int bj = 0; bj < 2; ++bj) { const v2u a = *(const v2u*)(gp + bj * HALF), b = *(const v2u*)(gp + DM + bj * HALF);
#define GM_(n, e, AW, BW, K) acc[ai][bj][m][n][e] *= gate_f<K>(AW) * __builtin_amdgcn_rcpf(gate_f<K>(BW))
                    GM_(0, 0, a.x, b.x, 0); GM_(0, 1, a.x, b.x, 1); GM_(0, 2, a.x, b.x, 2); GM_(0, 3, a.x, b.x, 3); GM_(1, 0, a.y, b.y, 0); GM_(1, 1, a.y, b.y, 1); GM_(1, 2, a.y, b.y, 2); GM_(1, 3, a.y, b.y, 3);
#undef GM_
                } }
    }
    __device__ __forceinline__ void operator()(const Acc& acc, const Unit& u, int wr, int wc, int fr, int fq) const {
        const int row0 = u.pm * BM + wr * 64 + fr, col0 = u.pn * BM + wc * 32 + 8 * fq;
        v2u gb[2][4][2];
#pragma unroll
        for (int ai = 0; ai < 2; ++ai)
#pragma unroll
            for (int m = 0; m < 4; ++m) { const size_t r = (size_t)(row0 + ai * HALF + m * 16);
#pragma unroll
                for (int bj = 0; bj < 2; ++bj) gb[ai][m][bj] = *(const v2u*)((const unsigned char*)(P + r * IN_W) + GATE_B0 + DM + col0 + bj * HALF); }
        asm volatile("" ::: "memory");
#pragma unroll
        for (int ai = 0; ai < 2; ++ai)
#pragma unroll
            for (int m = 0; m < 4; ++m) { const size_t r = (size_t)(row0 + ai * HALF + m * 16);
#pragma unroll
                for (int bj = 0; bj < 2; ++bj) { const v2u b = gb[ai][m][bj];
                    const float s[8] = {gate_f<0>(b.x), gate_f<1>(b.x), gate_f<2>(b.x), gate_f<3>(b.x), gate_f<0>(b.y), gate_f<1>(b.y), gate_f<2>(b.y), gate_f<3>(b.y)};
                    const f32x4 v0 = acc[ai][bj][m][0], v1 = acc[ai][bj][m][1]; constexpr float SC = (float)(1 << L_MG);
                    v2u w; w.x = pk4_fp8(v0[0] * s[0] * SC, v0[1] * s[1] * SC, v0[2] * s[2] * SC, v0[3] * s[3] * SC); w.y = pk4_fp8(v1[0] * s[4] * SC, v1[1] * s[5] * SC, v1[2] * s[6] * SC, v1[3] * s[7] * SC);
                    *(v2u*)(O + r * DM + col0 + bj * HALF) = w; } }
    }
};
template <bool XH> struct EpiRes {
    static constexpr bool PERM = true, PAIRED = false;
    const float* xp; const float* xs; const unsigned short* xh; unsigned short* out; const float* gate;
    __device__ __forceinline__ void operator()(const Acc& acc, const Unit& u, int wr, int wc, int fr, int fq) const {
        const int row0 = u.pm * BM + wr * 64 + fr, col0 = u.pn * BM + wc * 32 + 8 * fq;
        const int b = u.pm < 32 ? 0 : 1 + ((u.pm - 32) >> 4);
        const float* xb = u.pm < 32 ? xp : xs - (size_t)SEQ_P * DM;
        const float* gp = gate + (size_t)b * NMOD * DM + col0;
        f32x4 gv[2][2];
#pragma unroll
        for (int bj = 0; bj < 2; ++bj)
#pragma unroll
            for (int n = 0; n < 2; ++n) gv[bj][n] = *(const f32x4*)(gp + bj * HALF + n * 4);
#pragma unroll
        for (int ai = 0; ai < 2; ++ai) {
            f32x4 xv[4][2][2]; v4u hv[4][2];
#pragma unroll
            for (int m = 0; m < 4; ++m) { const size_t off = (size_t)(row0 + ai * HALF + m * 16) * DM + col0;
#pragma unroll
                for (int bj = 0; bj < 2; ++bj) {
                    if constexpr (XH) hv[m][bj] = *(const v4u*)(xh + off + bj * HALF);
                    else { xv[m][bj][0] = *(const f32x4*)(xb + off + bj * HALF); xv[m][bj][1] = *(const f32x4*)(xb + off + bj * HALF + 4); } } }
            asm volatile("" ::: "memory");
#pragma unroll
            for (int m = 0; m < 4; ++m) { const size_t off = (size_t)(row0 + ai * HALF + m * 16) * DM + col0;
#pragma unroll
                for (int bj = 0; bj < 2; ++bj) { f32x4 x0, x1;
                    if constexpr (XH) { const v4u h = hv[m][bj]; x0 = (f32x4){h_lo(h.x), h_hi(h.x), h_lo(h.y), h_hi(h.y)}; x1 = (f32x4){h_lo(h.z), h_hi(h.z), h_lo(h.w), h_hi(h.w)}; }
                    else { x0 = xv[m][bj][0]; x1 = xv[m][bj][1]; }
                    const f32x4 t0 = x0 * ALPHA + gv[bj][0] * acc[ai][bj][m][0], t1 = x1 * ALPHA + gv[bj][1] * acc[ai][bj][m][1];
                    v4u w; w.x = pk_h2(t0[0], t0[1]); w.y = pk_h2(t0[2], t0[3]); w.z = pk_h2(t1[0], t1[1]); w.w = pk_h2(t1[2], t1[3]);
                    __builtin_nontemporal_store(w, (v4u*)(out + off + bj * HALF)); } }
            asm volatile("" ::: "memory");
        }
    }
};
struct EpiSwiglu {
    static constexpr bool PERM = true, PAIRED = false;
    bf16* O; const float* rs; const float* cs;
    __device__ __forceinline__ void operator()(const Acc& acc, const Unit& u, int wr, int wc, int fr, int fq) const {
        const int row0 = u.pm * BM + wr * 64 + fr, col0 = u.pn * HALF + wc * 32 + 8 * fq;
        const float* cp = cs + u.pn * BM + wc * 32 + 8 * fq;
        const f32x4 cg0 = *(const f32x4*)cp, cg1 = *(const f32x4*)(cp + 4), cu0 = *(const f32x4*)(cp + HALF), cu1 = *(const f32x4*)(cp + HALF + 4);
        float rsv[2][4];
#pragma unroll
        for (int ai = 0; ai < 2; ++ai)
#pragma unroll
            for (int m = 0; m < 4; ++m) rsv[ai][m] = rs[row0 + ai * HALF + m * 16];
        asm volatile("" ::: "memory");
#pragma unroll
        for (int ai = 0; ai < 2; ++ai)
#pragma unroll
            for (int m = 0; m < 4; ++m) { float v[8]; const int r = row0 + ai * HALF + m * 16; const float rsc = rsv[ai][m];
#pragma unroll
                for (int n = 0; n < 2; ++n)
#pragma unroll
                    for (int e = 0; e < 4; ++e) { const float g = (float)__float_as_int(acc[ai][0][m][n][e]) * (rsc * (n ? cg1[e] : cg0[e])), up = (float)__float_as_int(acc[ai][1][m][n][e]) * (rsc * (n ? cu1[e] : cu0[e])); v[n * 4 + e] = g * sigmoidf_(g) * up; }
                v4u w; w.x = cvt_pk_bf16(v[0], v[1]); w.y = cvt_pk_bf16(v[2], v[3]); w.z = cvt_pk_bf16(v[4], v[5]); w.w = cvt_pk_bf16(v[6], v[7]);
                __builtin_nontemporal_store(w, (v4u*)(O + (size_t)r * DFF + col0)); }
    }
};

template <class Epi, bool INT> struct EpiHalf {
    static constexpr bool PERM = Epi::PERM, PAIRED = true; Epi e;
    __device__ __forceinline__ void mid(Acc&, const Unit&, int, int, int, int) const {}
    __device__ __forceinline__ void operator()(Acc& acc, const Unit& u, int wr, int wc, int fr, int fq) const {
#pragma unroll
        for (int a = 0; a < 2; ++a)
#pragma unroll
            for (int b = 0; b < 2; ++b)
#pragma unroll
                for (int m = 0; m < 4; ++m)
#pragma unroll
                    for (int n = 0; n < 2; ++n)
#pragma unroll
                        for (int q = 0; q < 4; ++q) { if (INT) acc[a][b][m][n][q] = __int_as_float(__float_as_int(acc[a][b][m][n][q]) >> 1); else acc[a][b][m][n][q] *= 0.5f; }
        e(acc, u, wr, wc, fr, fq);
    }
};
template <class Epi, class Sched, int GM>
__device__ __forceinline__ void gemm_phase(LAS unsigned char* lds, const Gemm g, const Sched& S, Epi E) {
    const int tid = tid_fresh(), wid = __builtin_amdgcn_readfirstlane(tid >> 6), lane = tid & 63, wr = wid >> 2, wc = wid & 3, fr = lane & 15, fq = lane >> 4;
    constexpr bool F8 = GM == 1;
    const int nt = g.kbytes / (BK * 2);
    const int sclA = g.sa, sclB = g.sb;
    unsigned voffA[2], voffB[2];
#pragma unroll
    for (int i = 0; i < 2; ++i) { int R, C; stage_rc(tid * 16 + i * 8192, R, C); const int Rb = Epi::PERM ? ((R & ~31) + perm32(R & 31)) : R;
        voffA[i] = (unsigned)(R * g.lda + C * 2); voffB[i] = (unsigned)(Rb * g.ldb + C * 2); }
    const size_t kstep = (size_t)(BK * 2);
    const size_t hstepA = (size_t)HALF * g.lda, hstepB = (size_t)HALF * g.ldb;
    const unsigned ldsw = (unsigned)wid * 1024u;
    const int aoff = lds_byte(wr * 64 + fr, fq * 8), boff = lds_byte(wc * 32 + fr, fq * 8);
#define PG8_SA(b, h) (((b) * 2 + (h)) * HTB)
#define PG8_SB(b, h) ((4 + (b) * 2 + (h)) * HTB)
#define PG8_STAGE(bufoff, gbase, voff) do { _Pragma("unroll") for (int _i = 0; _i < 2; ++_i) \
        __builtin_amdgcn_global_load_lds((const unsigned*)((const char*)(gbase) + (voff)[_i]), (LAS unsigned*)(lds + (bufoff) + ldsw + _i * 8192), 16, 0, 0); } while (0)
#define PG8_CAT(p) __builtin_shufflevector(*(const LAS v4i*)(p), *(const LAS v4i*)((p) + 1024), 0, 1, 2, 3, 4, 5, 6, 7)
#define PG8_LDA(dst, b, h) do { if constexpr (F8) { _Pragma("unroll") for (int m = 0; m < 4; ++m) dst##8[m] = PG8_CAT(lds + PG8_SA(b, h) + aoff + m * 2048); } \
        else { _Pragma("unroll") for (int m = 0; m < 4; ++m) _Pragma("unroll") for (int k = 0; k < 2; ++k) dst[m][k] = *(const LAS bf16x8*)(lds + PG8_SA(b, h) + aoff + m * 2048 + k * 1024); } } while (0)
#define PG8_LDB(dst, b, h) do { if constexpr (F8) { _Pragma("unroll") for (int n = 0; n < 2; ++n) dst##8[n] = PG8_CAT(lds + PG8_SB(b, h) + boff + n * 2048); } \
        else { _Pragma("unroll") for (int n = 0; n < 2; ++n) _Pragma("unroll") for (int k = 0; k < 2; ++k) dst[n][k] = *(const LAS bf16x8*)(lds + PG8_SB(b, h) + boff + n * 2048 + k * 1024); } } while (0)
#define PG8_MMA(ai, bj, At, Bt) do { __builtin_amdgcn_s_setprio(1); if constexpr (F8) { _Pragma("unroll") for (int m = 0; m < 4; ++m) _Pragma("unroll") for (int n = 0; n < 2; ++n) \
            asm volatile("v_mfma_scale_f32_16x16x128_f8f6f4 %0, %1, %2, %0, %3, %4 op_sel_hi:[0,0,0]" : "+v"(acc[ai][bj][m][n]) : "v"(Bt##8[n]), "v"(At##8[m]), "v"(sclB), "v"(sclA)); } \
        else if constexpr (GM == 2) { _Pragma("unroll") for (int m = 0; m < 4; ++m) _Pragma("unroll") for (int n = 0; n < 2; ++n) _Pragma("unroll") for (int k = 0; k < 2; ++k) \
        acc[ai][bj][m][n] = __builtin_bit_cast(f32x4, __builtin_amdgcn_mfma_i32_16x16x64_i8(__builtin_bit_cast(v4i, Bt[n][k]), __builtin_bit_cast(v4i, At[m][k]), __builtin_bit_cast(v4i, acc[ai][bj][m][n]), 0, 0, 0)); } \
        else { _Pragma("unroll") for (int m = 0; m < 4; ++m) _Pragma("unroll") for (int n = 0; n < 2; ++n) _Pragma("unroll") for (int k = 0; k < 2; ++k) \
        acc[ai][bj][m][n] = __builtin_amdgcn_mfma_f32_16x16x32_bf16(Bt[n][k], At[m][k], acc[ai][bj][m][n], 0, 0, 0); } __builtin_amdgcn_s_setprio(0); } while (0)
#define PG8_WAIT_V(n) asm volatile("s_waitcnt vmcnt(" #n ")" ::: "memory")
#define PG8_WAIT_L(n) asm volatile("s_waitcnt lgkmcnt(" #n ")" ::: "memory")
#define PG8_BAR __builtin_amdgcn_s_barrier()
#define PG8_SCHED __builtin_amdgcn_sched_barrier(0)
#define PG8_UA(u) ((const char*)g.A + (size_t)(u).pm * 2 * hstepA + (size_t)(u).kh * g.khoff)
#define PG8_UB(u) ((const char*)g.Bt + (size_t)(u).pn * 2 * hstepB + (size_t)(u).kh * g.khoff)
    Unit cur, nxt; int ui = 0;
    if (!S.next(0, cur)) return;
    Acc acc;
#pragma unroll
    for (int a = 0; a < 2; ++a)
#pragma unroll
        for (int b = 0; b < 2; ++b)
#pragma unroll
            for (int m = 0; m < 4; ++m)
#pragma unroll
                for (int n = 0; n < 2; ++n) acc[a][b][m][n] = (f32x4){0.f, 0.f, 0.f, 0.f};
    bf16x8 At[4][2], B0[2][2], B1[2][2]; v8i At8[4], B08[2], B18[2];
    const char* cA = PG8_UA(cur); const char* cB = PG8_UB(cur);
    PG8_STAGE(PG8_SB(0, 0), cB, voffB); PG8_STAGE(PG8_SB(0, 1), cB + hstepB, voffB); PG8_STAGE(PG8_SA(0, 0), cA, voffA); PG8_STAGE(PG8_SA(0, 1), cA + hstepA, voffA);
    if (wr == 1) PG8_BAR;
    PG8_WAIT_V(2); PG8_BAR;
    PG8_STAGE(PG8_SB(1, 0), cB + kstep, voffB); PG8_STAGE(PG8_SA(1, 0), cA + kstep, voffA); PG8_STAGE(PG8_SB(1, 1), cB + hstepB + kstep, voffB);
    PG8_WAIT_V(6); PG8_BAR;
    for (;;) {
        const bool has_next = S.next(ui + 1, nxt);
        const char* nA = has_next ? PG8_UA(nxt) : cA; const char* nB = has_next ? PG8_UB(nxt) : cB;
        for (int t = 0; t < nt; t += 2) {
            const bool last = (t == nt - 2);
            const char* a1 = cA + (size_t)(t + 1) * kstep;
            const char* a2 = last ? nA : cA + (size_t)(t + 2) * kstep; const char* b2 = last ? nB : cB + (size_t)(t + 2) * kstep;
            const char* a3 = a2 + kstep; const char* b3 = b2 + kstep;
            PG8_LDB(B0, 0, 0); PG8_LDB(B1, 0, 1); PG8_SCHED; PG8_LDA(At, 0, 0); PG8_STAGE(PG8_SA(1, 1), a1 + hstepA, voffA);
            PG8_WAIT_V(8); PG8_WAIT_L(0); PG8_BAR; PG8_MMA(0, 0, At, B0); PG8_MMA(0, 1, At, B1); PG8_BAR; PG8_SCHED;
            PG8_LDA(At, 0, 1); PG8_STAGE(PG8_SB(0, 0), b2, voffB); PG8_STAGE(PG8_SB(0, 1), b2 + hstepB, voffB); PG8_STAGE(PG8_SA(0, 0), a2, voffA);
            PG8_WAIT_V(8); PG8_WAIT_L(0); PG8_BAR; PG8_MMA(1, 0, At, B0); PG8_MMA(1, 1, At, B1); PG8_BAR; PG8_SCHED;
            PG8_LDB(B0, 1, 0); PG8_LDB(B1, 1, 1); PG8_SCHED; PG8_LDA(At, 1, 0); PG8_STAGE(PG8_SA(0, 1), a2 + hstepA, voffA);
            PG8_WAIT_V(8); PG8_WAIT_L(0); PG8_BAR; PG8_MMA(0, 0, At, B0); PG8_MMA(0, 1, At, B1); PG8_BAR; PG8_SCHED;
            PG8_LDA(At, 1, 1); PG8_STAGE(PG8_SB(1, 0), b3, voffB); PG8_STAGE(PG8_SB(1, 1), b3 + hstepB, voffB); PG8_STAGE(PG8_SA(1, 0), a3, voffA);
            PG8_WAIT_V(8); PG8_WAIT_L(0); PG8_BAR; PG8_MMA(1, 0, At, B0); PG8_MMA(1, 1, At, B1); PG8_BAR; PG8_SCHED;
        }
        if constexpr (F8) asm volatile("s_nop 7\n\ts_nop 7\n\ts_nop 7" ::: "memory");
        if (wr == 0) PG8_BAR;
        bool keep = false;
        if constexpr (Epi::PAIRED) { if (cur.kh == 0) { E.mid(acc, cur, wr, wc, fr, fq); keep = true; } }
        if (!keep) E(acc, cur, wr, wc, fr, fq);
        if (!has_next) break;
        if (!keep) {
#pragma unroll
            for (int a = 0; a < 2; ++a)
#pragma unroll
                for (int b = 0; b < 2; ++b)
#pragma unroll
                    for (int m = 0; m < 4; ++m)
#pragma unroll
                        for (int n = 0; n < 2; ++n) acc[a][b][m][n] = (f32x4){0.f, 0.f, 0.f, 0.f};
        }
        cur = nxt; cA = nA; cB = nB; ++ui;
        if (wr == 1) PG8_BAR;
    }
    PG8_WAIT_V(0);
    PG8_BAR;
#undef PG8_SA
#undef PG8_SB
#undef PG8_STAGE
#undef PG8_LDA
#undef PG8_CAT
#undef PG8_LDB
#undef PG8_MMA
#undef PG8_WAIT_V
#undef PG8_WAIT_L
#undef PG8_BAR
#undef PG8_SCHED
#undef PG8_UA
#undef PG8_UB
}
}

namespace att {
constexpr int D = 128, NW = 8, QBLK = 32, KVBLK = 64;
constexpr float SCALE = ATT_SCALE, THR = 8.f;
constexpr int LDQ = IN_W, LDK = IN_W, LDO = DM;
constexpr int SHM_V = KVBLK * D * 2, SHM_K = KVBLK * D * 2, SHM_ATTN = 2 * SHM_V + 2 * SHM_K + NW * 64 * 4;
#define KSWZ(row, colB) ((row) * 256 + ((colB) ^ (((row) & 7) << 4)))
#define SBAR() __builtin_amdgcn_sched_barrier(0)
__device__ __forceinline__ int crow(int r, int hi) { return (r & 3) + 8 * (r >> 2) + 4 * hi; }
__device__ __forceinline__ void partialSM(f32x16& p0, f32x16& p1, float& m_reg, float& mn, float& alpha) {
  constexpr float C = SCALE * 1.4426950408889634f;
  float pmax = p0[0];
#pragma unroll
  for (int r = 1; r < 16; ++r) pmax = fmaxf(pmax, p0[r]);
#pragma unroll
  for (int r = 0; r < 16; ++r) pmax = fmaxf(pmax, p1[r]);
  { auto rr = __builtin_amdgcn_permlane32_swap(__float_as_uint(pmax), __float_as_uint(pmax), false, false);
    pmax = fmaxf(__uint_as_float(rr[0]), __uint_as_float(rr[1])); }
  if (__builtin_expect(__all(pmax - m_reg <= THR / SCALE), 1)) { mn = m_reg; alpha = 1.f; }
  else { mn = fmaxf(m_reg, pmax); alpha = __builtin_amdgcn_exp2f((m_reg - mn) * C); m_reg = mn; }
  float mnC = -mn * C;
#pragma unroll
  for (int r = 0; r < 16; ++r) p0[r] = fmaf(p0[r], C, mnC);
#pragma unroll
  for (int r = 0; r < 16; ++r) p1[r] = fmaf(p1[r], C, mnC);
#pragma unroll
  for (int r = 0; r < 16; ++r) p0[r] = __builtin_amdgcn_exp2f(p0[r]);
}
__device__ __forceinline__ void finishSM(f32x16& p0, f32x16& p1, float alpha, float& l_reg, bf16x8& pa0, bf16x8& pa1, bf16x8& pa2, bf16x8& pa3) {
#pragma unroll
  for (int r = 0; r < 16; ++r) p1[r] = __builtin_amdgcn_exp2f(p1[r]);
  float ps = 0;
#pragma unroll
  for (int r = 0; r < 16; ++r) ps += p0[r];
#pragma unroll
  for (int r = 0; r < 16; ++r) ps += p1[r];
  { auto rr = __builtin_amdgcn_permlane32_swap(__float_as_uint(ps), __float_as_uint(ps), false, false);
    ps = __uint_as_float(rr[0]) + __uint_as_float(rr[1]); }
  l_reg = l_reg * alpha + ps;
#define PK4(P, BASE, OUT) do { unsigned a0 = cvt_pk_bf16(P[BASE + 0], P[BASE + 1]), a1 = cvt_pk_bf16(P[BASE + 2], P[BASE + 3]);   \
    unsigned b0 = cvt_pk_bf16(P[BASE + 4], P[BASE + 5]), b1 = cvt_pk_bf16(P[BASE + 6], P[BASE + 7]);                              \
    auto r0 = __builtin_amdgcn_permlane32_swap(a0, b0, false, false); auto r1 = __builtin_amdgcn_permlane32_swap(a1, b1, false, false); \
    v4u w = {r0[0], r1[0], r0[1], r1[1]}; OUT = *reinterpret_cast<bf16x8*>(&w); } while (0)
  PK4(p0, 0, pa0); PK4(p0, 8, pa1); PK4(p1, 0, pa2); PK4(p1, 8, pa3);
#undef PK4
}
__device__ __forceinline__ void qkt(f32x16& p0, f32x16& p1, const char* Ks, const bf16x8* qr, int r32, int hi) {
  p0 = f32x16{}; p1 = f32x16{};
#pragma unroll
  for (int d0 = 0; d0 < 8; ++d0) { int cb = (d0 * 16 + hi * 8) * 2;
    bf16x8 b0 = *reinterpret_cast<const bf16x8*>(Ks + KSWZ(r32, cb));
    bf16x8 b1 = *reinterpret_cast<const bf16x8*>(Ks + KSWZ(32 + r32, cb));
    p0 = __builtin_amdgcn_mfma_f32_32x32x16_bf16(b0, qr[d0], p0, 0, 0, 0);
    p1 = __builtin_amdgcn_mfma_f32_32x32x16_bf16(b1, qr[d0], p1, 0, 0, 0); }
}
__device__ __forceinline__ void win_bias(f32x16& p0, f32x16& p1, int dq, float sl) {
  const float NEG = -__builtin_inff();
#pragma unroll
  for (int r = 0; r < 16; ++r) { const int c = (r & 3) + 8 * (r >> 2);
    const int d0 = dq - c, d1 = dq - c - 32; const int a0 = d0 < 0 ? -d0 : d0, a1 = d1 < 0 ? -d1 : d1;
    p0[r] = a0 <= 128 ? fmaf(-sl, (float)a0, p0[r]) : NEG;
    p1[r] = a1 <= 128 ? fmaf(-sl, (float)a1, p1[r]) : NEG; }
}
__device__ __forceinline__ int v_st(int k, int c) { const int kk = (k & ~0xC) | ((k & 4) << 1) | ((k & 8) >> 1); return ((kk >> 3) * 4 + (c >> 5)) * 512 + ((kk & 7) * 32 + (c & 31)) * 2; }
__device__ __forceinline__ int v_rd_base(int lane) { return ((lane & 3) << 3) | (((lane >> 2) & 3) << 6) | (((lane >> 4) & 1) << 5) | (((lane >> 5) & 1) << 8); }
constexpr int v_rd_off(int d0, int ks, int half) { return d0 * 512 + ks * 4096 + half * 2048; }
template <int OFF> __device__ __forceinline__ s16x4 tr_read(int vb) {
  s16x4 r; asm volatile("ds_read_b64_tr_b16 %0, %1 offset:%2" : "=&v"(r) : "v"(vb), "i"(OFF) : "memory"); return r;
}
template <int D0> __device__ __forceinline__ void pv_one(f32x16& od, int vb, bf16x8 pa0, bf16x8 pa1, bf16x8 pa2, bf16x8 pa3) {
  const s16x4 l0 = tr_read<v_rd_off(D0, 0, 0)>(vb), h0 = tr_read<v_rd_off(D0, 0, 1)>(vb), l1 = tr_read<v_rd_off(D0, 1, 0)>(vb), h1 = tr_read<v_rd_off(D0, 1, 1)>(vb);
  const s16x4 l2 = tr_read<v_rd_off(D0, 2, 0)>(vb), h2 = tr_read<v_rd_off(D0, 2, 1)>(vb), l3 = tr_read<v_rd_off(D0, 3, 0)>(vb), h3 = tr_read<v_rd_off(D0, 3, 1)>(vb);
  asm volatile("s_waitcnt lgkmcnt(0)" ::: "memory"); SBAR();
#define PK(L, H) (bf16x8){L[0], L[1], L[2], L[3], H[0], H[1], H[2], H[3]}
  od = __builtin_amdgcn_mfma_f32_32x32x16_bf16(PK(l0, h0), pa0, od, 0, 0, 0);
  od = __builtin_amdgcn_mfma_f32_32x32x16_bf16(PK(l1, h1), pa1, od, 0, 0, 0);
  od = __builtin_amdgcn_mfma_f32_32x32x16_bf16(PK(l2, h2), pa2, od, 0, 0, 0);
  od = __builtin_amdgcn_mfma_f32_32x32x16_bf16(PK(l3, h3), pa3, od, 0, 0, 0);
#undef PK
}
__device__ __forceinline__ void pv_d0(f32x16* o, int vb, bf16x8 pa0, bf16x8 pa1, bf16x8 pa2, bf16x8 pa3) {
  pv_one<0>(o[0], vb, pa0, pa1, pa2, pa3); pv_one<1>(o[1], vb, pa0, pa1, pa2, pa3); pv_one<2>(o[2], vb, pa0, pa1, pa2, pa3); pv_one<3>(o[3], vb, pa0, pa1, pa2, pa3);
}
template <int MODE, int SDEPTH>
__device__ __forceinline__ void attn_body(const bf16* __restrict__ Qb, const bf16* __restrict__ Kh, const bf16* __restrict__ Vh, unsigned char* __restrict__ Ob, int NT, char* lds, int qrel, float sl, float sink_raw) {
  const int tid = tid_fresh(), wid = tid >> 6, lane = tid & 63, r32 = lane & 31, hi = lane >> 5;
  char* V_lds = lds; char* K_lds = lds + 2 * SHM_V;
  float m_reg = MODE ? sink_raw : -1e30f, l_reg = MODE ? 1.f : 0.f; f32x16 o[4] = {}; bf16x8 qr[8];
  const int dq0 = qrel + wid * QBLK + r32 - 4 * hi;
  const bf16* Qw = Qb + (long)(wid * QBLK + r32) * LDQ + hi * 8;
#pragma unroll
  for (int d0 = 0; d0 < 8; ++d0) qr[d0] = *reinterpret_cast<const bf16x8*>(Qw + d0 * 16);
  const int sr = tid >> 4, sc = (tid & 15) * 8, vst0 = v_st(sr, sc), vst1 = v_st(32 + sr, sc);
  const int vb0 = (int)(uintptr_t)V_lds + v_rd_base(lane);
  struct { bf16x8 vs0, vs1, ks0, ks1; } sr_[SDEPTH];
#define SLOAD(i, k0) do { sr_[i].vs0 = *reinterpret_cast<const bf16x8*>(&Vh[(long)((k0) + sr) * LDK + sc]); sr_[i].vs1 = *reinterpret_cast<const bf16x8*>(&Vh[(long)((k0) + 32 + sr) * LDK + sc]); \
    sr_[i].ks0 = *reinterpret_cast<const bf16x8*>(&Kh[(long)((k0) + sr) * LDK + sc]); sr_[i].ks1 = *reinterpret_cast<const bf16x8*>(&Kh[(long)((k0) + 32 + sr) * LDK + sc]); } while (0)
#define SWRITE(b, i) do { *(bf16x8*)(V_lds + (b) * SHM_V + vst0) = sr_[i].vs0;          \
    *(bf16x8*)(V_lds + (b) * SHM_V + vst1) = sr_[i].vs1; int kc = sc * 2;               \
    *(bf16x8*)(K_lds + (b) * SHM_K + KSWZ(sr, kc)) = sr_[i].ks0;                       \
    *(bf16x8*)(K_lds + (b) * SHM_K + KSWZ(32 + sr, kc)) = sr_[i].ks1; } while (0)
#define SWAIT() do { if constexpr (SDEPTH == 2) asm volatile("s_waitcnt vmcnt(4)" ::: "memory"); else asm volatile("s_waitcnt vmcnt(0)" ::: "memory"); } while (0)
#define RESC(a) do { if (__any((a) < 1.f)) { _Pragma("unroll") for (int d = 0; d < 4; ++d) _Pragma("unroll") for (int r = 0; r < 16; ++r) o[d][r] *= (a); } } while (0)
#define WB(P0, P1, j) do { if (MODE) win_bias(P0, P1, dq0 - (j) * KVBLK, sl); } while (0)
  f32x16 pA0, pA1, pB0, pB1; float mnA, mnB, alA, alB; bf16x8 pa0, pa1, pa2, pa3;
  constexpr int SE = 0, SO = SDEPTH - 1;
  SLOAD(SE, 0); asm volatile("s_waitcnt vmcnt(0)" ::: "memory"); SWRITE(0, SE);
  if constexpr (SDEPTH == 1) SLOAD(SO, KVBLK);
  __syncthreads();
  qkt(pA0, pA1, K_lds, qr, r32, hi); WB(pA0, pA1, 0); partialSM(pA0, pA1, m_reg, mnA, alA);
  if constexpr (SDEPTH == 2) { SLOAD(SO, KVBLK); if (2 < NT) SLOAD(SE, 2 * KVBLK); }
  SWAIT(); SWRITE(1, SO); __syncthreads();
  for (int j = 1; j + 1 < NT; j += 2) {
    SBAR(); qkt(pB0, pB1, K_lds + SHM_K, qr, r32, hi);
    finishSM(pA0, pA1, alA, l_reg, pa0, pa1, pa2, pa3); SBAR();
    SLOAD(SO, (j + SDEPTH) * KVBLK); SBAR();
    pv_d0(o, vb0, pa0, pa1, pa2, pa3); WB(pB0, pB1, j); partialSM(pB0, pB1, m_reg, mnB, alB);
    __syncthreads(); SWAIT(); SWRITE(0, SE);
    RESC(alB); __syncthreads();
    SBAR(); qkt(pA0, pA1, K_lds, qr, r32, hi);
    finishSM(pB0, pB1, alB, l_reg, pa0, pa1, pa2, pa3); SBAR();
    if (SDEPTH == 1 || j + 3 < NT) SLOAD(SE, (j + 1 + SDEPTH) * KVBLK); SBAR();
    pv_d0(o, vb0 + (int)SHM_V, pa0, pa1, pa2, pa3); WB(pA0, pA1, j + 1); partialSM(pA0, pA1, m_reg, mnA, alA);
    __syncthreads(); SWAIT(); SWRITE(1, SO);
    RESC(alA); __syncthreads();
  }
  SBAR(); qkt(pB0, pB1, K_lds + SHM_K, qr, r32, hi);
  finishSM(pA0, pA1, alA, l_reg, pa0, pa1, pa2, pa3); SBAR();
  pv_d0(o, vb0, pa0, pa1, pa2, pa3); WB(pB0, pB1, NT - 1); partialSM(pB0, pB1, m_reg, mnB, alB);
  __syncthreads(); RESC(alB);
  finishSM(pB0, pB1, alB, l_reg, pa0, pa1, pa2, pa3); SBAR();
  pv_d0(o, vb0 + (int)SHM_V, pa0, pa1, pa2, pa3);
  { const float rl = __builtin_amdgcn_rcpf(l_reg) * (float)(1 << L_Y);
    unsigned char* Ow = Ob + (long)(wid * QBLK + r32) * LDO + 4 * hi;
#pragma unroll
    for (int d0 = 0; d0 < 4; ++d0)
#pragma unroll
      for (int g = 0; g < 4; ++g) *(unsigned*)(Ow + d0 * 32 + 8 * g) = pk4_fp8(o[d0][4 * g] * rl, o[d0][4 * g + 1] * rl, o[d0][4 * g + 2] * rl, o[d0][4 * g + 3] * rl); }
#undef SLOAD
#undef SWRITE
#undef SWAIT
#undef RESC
#undef WB
}
}


namespace att8 {
typedef int v4i __attribute__((ext_vector_type(4)));
typedef int v8i __attribute__((ext_vector_type(8)));
constexpr float SCALE = ATT_SCALE, THR = 3.f;
constexpr int TB = 8192;
constexpr int SC8 = (127 - L_QK) * 0x01010101;
constexpr int SC8Q = (127 - L_QK - 3) * 0x01010101;
constexpr float THR2 = THR * 1.4426950408889634f;
#define CAT8(p) __builtin_shufflevector(*(const v4i*)(p), *(const v4i*)((p) + 16), 0, 1, 2, 3, 4, 5, 6, 7)
__device__ __forceinline__ v8i cat8x(const char* base, int off) { return __builtin_shufflevector(*(const v4i*)(base + off), *(const v4i*)(base + (off ^ 16)), 0, 1, 2, 3, 4, 5, 6, 7); }
template <bool FIRST>
__device__ __forceinline__ void softmax8(f32x16& p0, f32x16& p1, f32x16& ci, f32x16& ls, f32x16* o, v8i& P8) {
  float pmax = p0[0];
#pragma unroll
  for (int r = 1; r < 16; ++r) pmax = fmaxf(pmax, p0[r]);
#pragma unroll
  for (int r = 0; r < 16; ++r) pmax = fmaxf(pmax, p1[r]);
  { auto rr = __builtin_amdgcn_permlane32_swap(__float_as_uint(pmax), __float_as_uint(pmax), false, false);
    pmax = fmaxf(__uint_as_float(rr[0]), __uint_as_float(rr[1])); }
  if (FIRST || !__all(pmax <= THR2 + (float)L_QK)) {
    const float d = FIRST ? pmax - (float)L_QK : fmaxf(pmax - (float)L_QK, 0.f);
#pragma unroll
    for (int r = 0; r < 16; ++r) { p0[r] -= d; p1[r] -= d; ci[r] -= d; }
    if (!FIRST) { const float alpha = __builtin_amdgcn_exp2f(-d);
#pragma unroll
      for (int r = 0; r < 16; ++r) ls[r] *= alpha;
#pragma unroll
      for (int db = 0; db < 4; ++db)
#pragma unroll
        for (int r = 0; r < 16; ++r) o[db][r] *= alpha; }
  }
#pragma unroll
  for (int r = 0; r < 16; ++r) { p0[r] = __builtin_amdgcn_exp2f(p0[r]); p1[r] = __builtin_amdgcn_exp2f(p1[r]); }
#pragma unroll
  for (int k = 0; k < 4; ++k) { int w = P8[k]; w = __builtin_amdgcn_cvt_pk_fp8_f32(p0[4 * k], p0[4 * k + 1], w, false); w = __builtin_amdgcn_cvt_pk_fp8_f32(p0[4 * k + 2], p0[4 * k + 3], w, true); P8[k] = w; }
#pragma unroll
  for (int k = 0; k < 4; ++k) { int w = P8[4 + k]; w = __builtin_amdgcn_cvt_pk_fp8_f32(p1[4 * k], p1[4 * k + 1], w, false); w = __builtin_amdgcn_cvt_pk_fp8_f32(p1[4 * k + 2], p1[4 * k + 3], w, true); P8[4 + k] = w; }
}
__device__ __forceinline__ void qkt8(f32x16& p0, f32x16& p1, const char* Kt, const v8i (&q8)[2], int ka0, int ka1, const f32x16& ci, const v8i& k00, const v8i& k10) {
  p0 = __builtin_amdgcn_mfma_scale_f32_32x32x64_f8f6f4(k00, q8[0], ci, 0, 0, 0, SC8, 0, SC8Q);
  p1 = __builtin_amdgcn_mfma_scale_f32_32x32x64_f8f6f4(k10, q8[0], ci, 0, 0, 0, SC8, 0, SC8Q);
  p0 = __builtin_amdgcn_mfma_scale_f32_32x32x64_f8f6f4(cat8x(Kt, ka1), q8[1], p0, 0, 0, 0, SC8, 0, SC8Q);
  p1 = __builtin_amdgcn_mfma_scale_f32_32x32x64_f8f6f4(cat8x(Kt + 4096, ka1), q8[1], p1, 0, 0, 0, SC8, 0, SC8Q);
}
__device__ __forceinline__ void pv8(f32x16* o, const char* Vt, const v8i& P8, int va, f32x16& ls, const v8i& ones) {
#pragma unroll
  for (int db = 0; db < 4; ++db) o[db] = __builtin_amdgcn_mfma_scale_f32_32x32x64_f8f6f4(cat8x(Vt + db * 2048, va), P8, o[db], 0, 0, 0, SC8, 0, SC8);
  ls = __builtin_amdgcn_mfma_scale_f32_32x32x64_f8f6f4(ones, P8, ls, 0, 0, 0, 127 * 0x01010101, 0, 127 * 0x01010101);
}
template <int MODE>
__device__ __forceinline__ void attn_a8(const unsigned char* __restrict__ Q8, const unsigned char* __restrict__ K8, const unsigned char* __restrict__ VT, unsigned char* __restrict__ Ob, int NT, char* lds, int qrel, float sl, float sink_raw) {
  const int tid = tid_fresh(), wid = tid >> 6, lane = tid & 63, r32 = lane & 31, hi = lane >> 5;
  char* K_lds = lds; char* V_lds = lds + 4 * TB;
  const float m_reg = MODE ? sink_raw : 0.f; f32x16 o[4] = {}; v8i q8[2];
  f32x16 ls; v8i ones;
  { float l0 = MODE ? (float)(1 << L_QK) : 0.f; int one4 = 0x38383838; asm volatile("" : "+v"(l0), "+v"(one4));
#pragma unroll
    for (int r = 0; r < 16; ++r) ls[r] = l0;
#pragma unroll
    for (int r = 0; r < 8; ++r) ones[r] = one4; }
  f32x16 ci;
  { float c0 = (float)L_QK - m_reg; asm volatile("" : "+v"(c0));
#pragma unroll
    for (int r = 0; r < 16; ++r) ci[r] = c0; }
  const int dq0 = qrel + wid * 32 + r32 - 4 * hi;
#define WB8(P0, P1, j) do { if (MODE) att::win_bias(P0, P1, dq0 - (j) * 64, sl); } while (0)
  { const unsigned char* qp = Q8 + (long)(wid * 32 + r32) * 2048 + 32 * hi; q8[0] = CAT8(qp); q8[1] = CAT8(qp + 64); }
  const int swk = (r32 >> 1) & 7, swv = (r32 >> 2) & 3;
  const int ka0 = r32 * 128 + (((0 + 2 * hi) ^ swk) << 4), ka1 = r32 * 128 + (((4 + 2 * hi) ^ swk) << 4);
  const int va = r32 * 64 + (((2 * hi) ^ swv) << 4);
  const int kr = tid >> 3, vd = tid >> 2; const bool late = wid >= 4;
  const unsigned goK = (unsigned)(kr * 512 + (((tid & 7) ^ ((kr >> 1) & 7)) << 4)), goV = (unsigned)(vd * 64 + (((tid & 3) ^ ((vd >> 2) & 3)) << 4));
  LAS char* const Lw = (LAS char*)lds + __builtin_amdgcn_readfirstlane(wid) * 1024;
#define DMAK8(j, rb) __builtin_amdgcn_global_load_lds((const unsigned*)((const char*)K8 + (size_t)(j) * (64 * 512) + goK), (LAS unsigned*)(Lw + (rb)), 16, 0, 0)
#define DMAV8(j, rb) __builtin_amdgcn_global_load_lds((const unsigned*)((const char*)VT + (size_t)(j) * (4 * TB) + goV), (LAS unsigned*)(Lw + 4 * TB + (rb)), 16, 0, 0)
#define WAITV8(n) asm volatile("s_waitcnt vmcnt(" #n ") lgkmcnt(0)" ::: "memory")
#define BAR8() do { __builtin_amdgcn_s_barrier(); asm volatile("" ::: "memory"); } while (0)
  f32x16 p0, p1; v8i P8 = {}, kf0, kf1;
#define KPRE8(KR) do { kf0 = cat8x(K_lds + (KR), ka0); kf1 = cat8x(K_lds + (KR) + 4096, ka0); } while (0)
  __syncthreads();
  DMAK8(0, 0); DMAV8(0, 0); DMAK8(1, TB); DMAK8(2, 2 * TB); WAITV8(0); BAR8();
  if (late) BAR8();
  __builtin_amdgcn_s_setprio(1);
  KPRE8(0);
  qkt8(p0, p1, K_lds, q8, ka0, ka1, ci, kf0, kf1); __builtin_amdgcn_sched_barrier(0);
  DMAK8(3 < NT ? 3 : NT - 1, 3 < NT ? 3 * TB : 8 * TB); DMAV8(1, TB);
  WAITV8(2);
  __builtin_amdgcn_s_setprio(0); BAR8();
  WB8(p0, p1, 0); softmax8<MODE == 0>(p0, p1, ci, ls, o, P8); KPRE8(TB); BAR8();
#define STEP8(t, KR, VR, KN) do { const int t_ = (t); const bool sk = t_ + 3 < NT, sv = t_ + 1 < NT; \
    __builtin_amdgcn_s_setprio(1); \
    qkt8(p0, p1, K_lds + (KR), q8, ka0, ka1, ci, kf0, kf1); __builtin_amdgcn_sched_barrier(0); \
    DMAK8(sk ? t_ + 3 : NT - 1, sk ? (VR) : 8 * TB); DMAV8(sv ? t_ + 1 : NT - 1, sv ? (KN) : 5 * TB);     \
    __builtin_amdgcn_sched_barrier(0); pv8(o, V_lds + (VR), P8, va, ls, ones); \
    WAITV8(2); \
    __builtin_amdgcn_s_setprio(0); BAR8(); \
    WB8(p0, p1, t_); softmax8<false>(p0, p1, ci, ls, o, P8); KPRE8(KN); BAR8(); } while (0)
  int t = 1;
  for (; t + 3 < NT; t += 4) { STEP8(t, TB, 0, 2 * TB); STEP8(t + 1, 2 * TB, TB, 3 * TB); STEP8(t + 2, 3 * TB, 2 * TB, 0); STEP8(t + 3, 0, 3 * TB, TB); }
  const int rem = NT - t;
  if (rem >= 1) STEP8(t, TB, 0, 2 * TB);
  if (rem >= 2) STEP8(t + 1, 2 * TB, TB, 3 * TB);
  if (rem >= 3) STEP8(t + 2, 3 * TB, 2 * TB, 0);
  if (rem == 0) pv8(o, V_lds, P8, va, ls, ones); else if (rem == 1) pv8(o, V_lds + TB, P8, va, ls, ones); else if (rem == 2) pv8(o, V_lds + 2 * TB, P8, va, ls, ones); else pv8(o, V_lds + 3 * TB, P8, va, ls, ones);
  WAITV8(0); BAR8();
  if (!late) BAR8();
#undef STEP8
#undef KPRE8
#undef DMAK8
#undef DMAV8
#undef WAITV8
#undef BAR8
  { const float rl = __builtin_amdgcn_rcpf(ls[0]) * (float)(1 << (L_Y + L_QK));
    const int t2 = tid_fresh(), w2 = t2 >> 6, l2 = t2 & 63; LAS char* st = (LAS char*)lds + w2 * 4096;
    { LAS char* sw = st + (l2 & 31) * 128 + 4 * (l2 >> 5);
#pragma unroll
      for (int d0 = 0; d0 < 4; ++d0)
#pragma unroll
        for (int g = 0; g < 4; ++g) *(LAS unsigned*)(sw + d0 * 32 + 8 * g) = pk4_fp8(o[d0][4 * g] * rl, o[d0][4 * g + 1] * rl, o[d0][4 * g + 2] * rl, o[d0][4 * g + 3] * rl); }
#pragma unroll
    for (int k = 0; k < 4; ++k) { const int row = 8 * k + (l2 >> 3), ch = l2 & 7;
      const v4i wv = *(const LAS v4i*)(st + row * 128 + ch * 16);
      *(v4i*)(Ob + (size_t)(w2 * 32 + row) * DM + ch * 16) = wv; }
    asm volatile("s_waitcnt lgkmcnt(0)" ::: "memory"); }
#undef WB8
}
#undef CAT8
}

#define XB_TMO      128
#define XB_XCNT(j)  (256  + 64 * (j))
#define XB_XSUB(j)  (1280 + 64 * (j))
#define XB_XGEN(j)  (2304 + 64 * (j))
#define XB_TOP      3328
#define XB_TOPGEN   3392
#define XCD_BAR_WORDS 3456
#define XB_SPIN_CAP (1u << 18)
__device__ __forceinline__ unsigned xb_ld(unsigned* p)              { return __hip_atomic_load(p, __ATOMIC_RELAXED, __HIP_MEMORY_SCOPE_AGENT); }
__device__ __forceinline__ unsigned xb_add(unsigned* p, unsigned v) { return __hip_atomic_fetch_add(p, v, __ATOMIC_RELAXED, __HIP_MEMORY_SCOPE_AGENT); }
__device__ __forceinline__ unsigned xb_xcc_id() { return (unsigned)__builtin_amdgcn_s_getreg((3 << 11) | 20) & 0xFu; }
#define XB_SPIN(cond, bar) do { unsigned _sp = 0; while (cond) { __builtin_amdgcn_s_sleep(1); \
    if ((++_sp & 255u) == 0u) { if (xb_ld(&(bar)[XB_TMO])) break; if (_sp > XB_SPIN_CAP) { atomicAdd(&(bar)[XB_TMO], 1u); break; } } } } while (0)
struct XcdBarrier { unsigned* bar; unsigned x; volatile LAS unsigned* st; };
__device__ __forceinline__ XcdBarrier xcd_barrier_post(unsigned* bar, volatile LAS unsigned* st) {
    XcdBarrier b; b.bar = bar; b.x = xb_xcc_id(); b.st = st;
    if (threadIdx.x == 0) (void)xb_add(&bar[XB_XCNT(b.x)], 1u);
    return b;
}
__device__ __forceinline__ void xcd_barrier_complete(unsigned* bar, unsigned x, unsigned& nloc, unsigned& nx) {
    const unsigned G = gridDim.x * gridDim.y * gridDim.z;
    unsigned sum, cnt, mine, sp = 0u;
    for (;;) {
        sum = 0u; cnt = 0u; mine = 0u;
#pragma unroll
        for (unsigned j = 0; j < 16; ++j) { const unsigned c = xb_ld(&bar[XB_XCNT(j)]); sum += c; cnt += (c > 0u) ? 1u : 0u; mine = (j == x) ? c : mine; }
        if (sum == G) break;
        __builtin_amdgcn_s_sleep(1);
        if ((++sp & 255u) == 0u) { if (xb_ld(&bar[XB_TMO])) break; if (sp > XB_SPIN_CAP) { atomicAdd(&bar[XB_TMO], 1u); break; } }
    }
    nloc = mine > 0u ? mine : 1u; nx = cnt > 0u ? cnt : 1u;
}
__device__ __forceinline__ void xcd_barrier(const XcdBarrier& b) {
    asm volatile("s_waitcnt vmcnt(0)" ::: "memory");
    __syncthreads();
    if (threadIdx.x == 0) {
        unsigned* bar = b.bar;
        __builtin_amdgcn_s_waitcnt(0);
        unsigned nloc = b.st[0], nx = b.st[1];
        if (nloc == 0u) { xcd_barrier_complete(bar, b.x, nloc, nx); b.st[0] = nloc; b.st[1] = nx; }
        const unsigned old = xb_add(&bar[XB_XSUB(b.x)], 1u);
        const unsigned gen = old / nloc;
        if (old + 1u == (gen + 1u) * nloc) {
            __builtin_amdgcn_fence(__ATOMIC_RELEASE, "agent");
            asm volatile("s_waitcnt vmcnt(0)" ::: "memory");
            const unsigned og = xb_add(&bar[XB_TOP], 1u);
            const unsigned tg = og / nx;
            if (og + 1u == (tg + 1u) * nx) xb_add(&bar[XB_TOPGEN], 1u);
            else XB_SPIN(xb_ld(&bar[XB_TOPGEN]) == tg, bar);
            __builtin_amdgcn_fence(__ATOMIC_ACQUIRE, "agent");
            xb_add(&bar[XB_XGEN(b.x)], 1u);
            asm volatile("s_waitcnt vmcnt(0)" ::: "memory");
        } else {
            XB_SPIN(xb_ld(&bar[XB_XGEN(b.x)]) == gen, bar);
            __builtin_amdgcn_fence(__ATOMIC_ACQUIRE, "agent");
            asm volatile("s_waitcnt vmcnt(0)" ::: "memory");
        }
    }
    __syncthreads();
}

struct Args { const float* in[20]; float* out; unsigned char* ws; int ph_lo, ph_hi; };
struct Frame {
    LAS unsigned char* lds;
    int tid, lane, wave, vcu, G;
    const float *xp, *xs, *cp, *cs, *w_ada, *b_ada, *w_in, *qn, *kn, *sink, *wbra, *wbrb, *wo, *ln1g, *ln1b, *wg, *wu, *wd, *ln2g, *ln2b;
    float* out; float* mod; float* rope; float* rsc; float* csc; unsigned* cmax;
    bf16 *Win_t, *Wbr_t, *Wo_t, *Wgu_t, *Wd_t, *H, *Y, *P;
    unsigned char *QA8, *KA8, *VT8, *QB8, *KB8, *VTB8;
};
typedef const __attribute__((address_space(4))) Args* KArgs;
__device__ __forceinline__ void frame_ptrs(Frame& F) {
    unsigned long long kp = (unsigned long long)__builtin_amdgcn_kernarg_segment_ptr(); asm volatile("" : "+s"(kp));
    KArgs a = (KArgs)kp; unsigned char* ws = a->ws;
    F.tid = tid_fresh(); F.lane = F.tid & 63; F.wave = __builtin_amdgcn_readfirstlane(F.tid >> 6);
    F.xp = a->in[0]; F.xs = a->in[1]; F.cp = a->in[2]; F.cs = a->in[3]; F.w_ada = a->in[4]; F.b_ada = a->in[5]; F.w_in = a->in[6]; F.qn = a->in[7]; F.kn = a->in[8]; F.sink = a->in[9];
    F.wbra = a->in[10]; F.wbrb = a->in[11]; F.wo = a->in[12]; F.ln1g = a->in[13]; F.ln1b = a->in[14]; F.wg = a->in[15]; F.wu = a->in[16]; F.wd = a->in[17]; F.ln2g = a->in[18]; F.ln2b = a->in[19];
    F.out = a->out; F.mod = (float*)(ws + WS_MOD); F.rope = (float*)(ws + WS_ROPE); F.rsc = (float*)(ws + WS_RSC); F.csc = (float*)(ws + WS_CSC); F.cmax = (unsigned*)(ws + WS_CTL) + CW_CMAX;
    F.Win_t = (bf16*)(ws + WS_WIN); F.Wbr_t = (bf16*)(ws + WS_WBR); F.Wo_t = (bf16*)(ws + WS_WO); F.Wgu_t = (bf16*)(ws + WS_WGU); F.Wd_t = (bf16*)(ws + WS_WD);
    F.H = (bf16*)(ws + WS_H); F.Y = (bf16*)(ws + WS_Y); F.P = (bf16*)(ws + WS_P);
    F.QA8 = ws + WS_QA8; F.KA8 = ws + WS_KA8; F.VT8 = ws + WS_VT8; F.QB8 = ws + WS_QB8; F.KB8 = ws + WS_KB8; F.VTB8 = ws + WS_VTB8;
}
__device__ __forceinline__ float wave_sum(float v) {
#pragma unroll
    for (int o = 1; o < 64; o <<= 1) v += __shfl_xor(v, o);
    return v;
}
__device__ __forceinline__ void p0_transpose_tile(const float* W, int N, int k0, int n0, bf16* WT, int dst_row0, int dst_k0, int ldk, LAS float* scr, int lane) {
    { f32x4 t_[8]; const int c4 = 4 * (lane & 7);
#pragma unroll
      for (int i = 0; i < 8; ++i) t_[i] = __builtin_nontemporal_load((const f32x4*)(W + (size_t)(k0 + 8 * i + (lane >> 3)) * N + n0 + c4));
#pragma unroll
      for (int i = 0; i < 8; ++i) { LAS float* d_ = scr + (8 * i + (lane >> 3)) * 33 + c4; d_[0] = t_[i][0]; d_[1] = t_[i][1]; d_[2] = t_[i][2]; d_[3] = t_[i][3]; } }
    LDS_WAIT(); asm volatile("" ::: "memory");
    const int c = lane & 7;
#pragma unroll
    for (int j = 0; j < 4; ++j) { const int n = (lane >> 3) + 8 * j; const LAS float* s = scr + (8 * c) * 33 + n;
        v4u o; o.x = cvt_pk_bf16(s[0 * 33], s[1 * 33]); o.y = cvt_pk_bf16(s[2 * 33], s[3 * 33]); o.z = cvt_pk_bf16(s[4 * 33], s[5 * 33]); o.w = cvt_pk_bf16(s[6 * 33], s[7 * 33]);
        *(GAS v4u*)(WT + (size_t)(dst_row0 + n) * ldk + dst_k0 + 8 * c) = o; }
    LDS_WAIT(); asm volatile("" ::: "memory");
}
template <bool QKP>
__device__ __forceinline__ void p0_transpose_tile_f8(const float* W, int N, int k0, int n0, unsigned char* WT, int dst_row0, int dst_k0, int ldk, float sc, LAS float* scr, int lane) {
    { f32x4 t_[8]; const int c4 = 4 * (lane & 7);
#pragma unroll
      for (int i = 0; i < 8; ++i) t_[i] = __builtin_nontemporal_load((const f32x4*)(W + (size_t)(k0 + 8 * i + (lane >> 3)) * N + n0 + c4));
#pragma unroll
      for (int i = 0; i < 8; ++i) { LAS float* d_ = scr + (8 * i + (lane >> 3)) * 33 + c4; d_[0] = t_[i][0]; d_[1] = t_[i][1]; d_[2] = t_[i][2]; d_[3] = t_[i][3]; } }
    LDS_WAIT(); asm volatile("" ::: "memory");
    const int c = lane & 7;
#pragma unroll
    for (int j = 0; j < 4; ++j) { const int n = (lane >> 3) + 8 * j; const LAS float* s = scr + (8 * c) * 33 + n;
        v2u o; o.x = pk4_fp8(s[0 * 33] * sc, s[1 * 33] * sc, s[2 * 33] * sc, s[3 * 33] * sc); o.y = pk4_fp8(s[4 * 33] * sc, s[5 * 33] * sc, s[6 * 33] * sc, s[7 * 33] * sc);
        const int t_ = (n0 >> 5) & 3; const int row = QKP ? (n0 & ~127) + 64 * (t_ >> 1) + 32 * (n >> 4) + 8 * ((n >> 2) & 3) + 4 * (t_ & 1) + (n & 3) : dst_row0 + n;
        *(GAS v2u*)(WT + (size_t)row * ldk + dst_k0 + 8 * c) = o; }
    LDS_WAIT(); asm volatile("" ::: "memory");
}
__device__ __forceinline__ void p0_transpose_tile_i8(const float* W, int N, int k0, int n0, unsigned char* WT, int dst_row0, int dst_k0, int ldk, const unsigned* cm, LAS float* scr, int lane) {
    { f32x4 t_[8]; const int c4 = 4 * (lane & 7);
#pragma unroll
      for (int i = 0; i < 8; ++i) t_[i] = __builtin_nontemporal_load((const f32x4*)(W + (size_t)(k0 + 8 * i + (lane >> 3)) * N + n0 + c4));
#pragma unroll
      for (int i = 0; i < 8; ++i) { LAS float* d_ = scr + (8 * i + (lane >> 3)) * 33 + c4; d_[0] = t_[i][0]; d_[1] = t_[i][1]; d_[2] = t_[i][2]; d_[3] = t_[i][3]; } }
    LDS_WAIT(); asm volatile("" ::: "memory");
    const int c = lane & 7;
#pragma unroll
    for (int j = 0; j < 4; ++j) { const int n = (lane >> 3) + 8 * j; const LAS float* s = scr + (8 * c) * 33 + n;
        const float mx = __uint_as_float(cm[dst_row0 + n]); const float inv = mx > 0.f ? 127.0f / mx : 0.f; int q[8];
#pragma unroll
        for (int e = 0; e < 8; ++e) q[e] = (int)__builtin_rintf(s[e * 33] * inv) & 0xff;
        v2u o; o.x = (unsigned)(q[0] | (q[1] << 8) | (q[2] << 16) | (q[3] << 24)); o.y = (unsigned)(q[4] | (q[5] << 8) | (q[6] << 16) | (q[7] << 24));
        *(GAS v2u*)(WT + (size_t)(dst_row0 + n) * ldk + dst_k0 + 8 * c) = o; }
    LDS_WAIT(); asm volatile("" ::: "memory");
}
__device__ __forceinline__ void sincos_poly(double y, double& s, double& c) {
    const double y2 = y * y; double ts = y, tc = 1.0; s = y; c = 1.0;
#pragma unroll
    for (int n = 1; n <= 15; ++n) { tc *= -y2 * (1.0 / (double)((2 * n - 1) * (2 * n))); c += tc; ts *= -y2 * (1.0 / (double)((2 * n) * (2 * n + 1))); s += ts; }
}

__device__ __forceinline__ void phase0(Frame& F) {
    LAS float* sc = (LAS float*)F.lds;
    LAS float* part = (LAS float*)(F.lds + 81920);
    for (int i = F.tid; i < NBATCH * DM; i += NWAVES * 64) { const float c = i < DM ? F.cp[i] : F.cs[i - DM]; sc[i] = c * sigmoidf_(c); }
    __syncthreads();
    for (int cb = F.vcu; cb < (NMOD * DM) / 96; cb += F.G) {
        if (F.tid < 504) { const int ct = F.tid % 24, kg = F.tid / 24; const float* wp = F.w_ada + (size_t)cb * 96 + 4 * ct;
            f32x4 a0 = {0, 0, 0, 0}, a1 = a0, a2 = a0, a3 = a0, a4 = a0;
#pragma unroll 4
            for (int k = kg; k < DM; k += 21) { const f32x4 wv = *(const f32x4*)(wp + (size_t)k * (NMOD * DM));
                a0 += wv * sc[k]; a1 += wv * sc[DM + k]; a2 += wv * sc[2 * DM + k]; a3 += wv * sc[3 * DM + k]; a4 += wv * sc[4 * DM + k]; }
            LAS f32x4* pp = (LAS f32x4*)(part + (kg * 24 + ct) * 20); pp[0] = a0; pp[1] = a1; pp[2] = a2; pp[3] = a3; pp[4] = a4; }
        __syncthreads();
        if (F.tid < 480) { const int b = F.tid / 96, j = F.tid % 96, ct = j >> 2, e = j & 3; float s = F.b_ada[cb * 96 + j];
            for (int kg = 0; kg < 21; ++kg) s += part[(kg * 24 + ct) * 20 + b * 4 + e];
            F.mod[(size_t)b * NMOD * DM + cb * 96 + j] = s; }
        __syncthreads();
    }
    { const int gt = F.vcu * NWAVES * 64 + F.tid;
      if (gt < 6144) { const int isc = gt >= 4096, idx = isc ? gt - 4096 : gt, pos = idx >> 5, i = idx & 31;
          double inv = 1.0; for (int k = 0; k < i; ++k) inv *= 0.7498942093324559;
          const double ang = (double)pos * inv; const double kq = __builtin_rint(ang * 0.15915494309189535); const double y = ang - kq * 6.283185307179586;
          double s, c; sincos_poly(y, s, c);
          float* cosp = F.rope + (isc ? 8192 : 0); float* sinp = cosp + (isc ? 2048 : 4096);
          cosp[idx] = (float)c; sinp[idx] = (float)s; } }
    LAS float* scr = (LAS float*)(F.lds + F.wave * 16384);
    const int gw = F.vcu * NWAVES + F.wave, NGW = F.G * NWAVES;
    constexpr int I_IN = (DM / 64) * (IN_W / 32);
    for (int it = gw; it < I_IN; it += NGW) { const int nb = IN_W / 32, kb = it / nb, n0 = 32 * (it % nb);
        if (n0 < C_VA) p0_transpose_tile_f8<true>(F.w_in, IN_W, 64 * kb, n0, (unsigned char*)F.Win_t, n0, 64 * kb, DM, (float)(1 << L_WIN), scr, F.lane);
        else p0_transpose_tile_f8<false>(F.w_in, IN_W, 64 * kb, n0, (unsigned char*)F.Win_t, n0, 64 * kb, DM, (float)(1 << L_WIN), scr, F.lane); }
}
__device__ __forceinline__ void side2(Frame& F) {
    LAS float* scr = (LAS float*)(F.lds + F.wave * 16384);
    const int gw = F.vcu * NWAVES + F.wave, NGW = F.G * NWAVES;
    constexpr int I_BR = (2048 / 64) * (DM / 32), I_O = (DM / 64) * (DM / 32), I_D = (DFF / 64) * (DM / 32);
    constexpr int NITEMS = 2 * I_BR + I_O + I_D;
    for (int it = gw; it < NITEMS; it += NGW) {
        int r = it;
        if (r < I_BR) { const int nb = DM / 32, kb = r / nb, n0 = 32 * (r % nb); p0_transpose_tile_f8<false>(F.wbra, DM, 64 * kb, n0, (unsigned char*)F.Wbr_t, n0, 64 * kb, DM, (float)(1 << L_WBR), scr, F.lane); continue; } r -= I_BR;
        if (r < I_BR) { const int nb = DM / 32, kb = r / nb, n0 = 32 * (r % nb); p0_transpose_tile_f8<false>(F.wbrb, DM, 64 * kb, n0, (unsigned char*)F.Wbr_t, n0, 2048 + 64 * kb, DM, (float)(1 << L_WBR), scr, F.lane); continue; } r -= I_BR;
        if (r < I_O) { const int nb = DM / 32, kb = r / nb, n0 = 32 * (r % nb); p0_transpose_tile_f8<false>(F.wo, DM, 64 * kb, n0, (unsigned char*)F.Wo_t, n0, 64 * kb, DM, (float)(1 << L_WO), scr, F.lane); continue; } r -= I_O;
        { const int nb = DM / 32, kb = r / nb, n0 = 32 * (r % nb); p0_transpose_tile(F.wd, DM, 64 * kb, n0, F.Wd_t, n0, 64 * kb, DFF, scr, F.lane); }
    }
    for (int it = gw; it < 2 * 16 * 43; it += NGW) { const int mat = it / (16 * 43), r = it % (16 * 43), ks = r / 43, cb = r % 43; const int c = cb * 256 + 4 * F.lane;
        const float* wp = (mat ? F.wu : F.wg) + (size_t)(ks * 256) * DFF + c; f32x4 mx = {0.f, 0.f, 0.f, 0.f};
#pragma unroll 8
        for (int k = 0; k < 256; ++k) { const f32x4 wv = __builtin_nontemporal_load((const f32x4*)(wp + (size_t)k * DFF)); mx = __builtin_elementwise_max(mx, __builtin_elementwise_abs(wv)); }
        unsigned* cm = F.cmax + 256 * (c >> 7) + (mat ? 128 : 0) + (c & 127);
#pragma unroll
        for (int e = 0; e < 4; ++e) atomicMax(cm + e, __float_as_uint(mx[e])); }
}
__device__ __forceinline__ void side4(Frame& F) {
    LAS float* scr = (LAS float*)(F.lds + F.wave * 16384);
    const int gw = F.vcu * NWAVES + F.wave, NGW = F.G * NWAVES;
    constexpr int I_G = (DM / 64) * (DFF / 32);
    for (int it = gw; it < 2 * I_G; it += NGW) { const int mat = it >= I_G, r = mat ? it - I_G : it; const int nb = DFF / 32, kb = r / nb, n0 = 32 * (r % nb);
        p0_transpose_tile_i8(mat ? F.wu : F.wg, DFF, 64 * kb, n0, (unsigned char*)F.Wgu_t, 256 * (n0 >> 7) + (mat ? 128 : 0) + (n0 & 127), 64 * kb, DM, F.cmax, scr, F.lane); }
    for (int i = F.vcu * NWAVES * 64 + F.tid; i < 2 * DFF; i += F.G * NWAVES * 64) F.csc[i] = __uint_as_float(F.cmax[i]) * (1.0f / 127.0f);
}
__device__ __forceinline__ void row_stats(const f32x4 (&v)[16], float& mean, float& rstd) {
    float s = 0.f;
#pragma unroll
    for (int j = 0; j < 16; ++j) s += (v[j].x + v[j].y) + (v[j].z + v[j].w);
    mean = wave_sum(s) * (1.f / DM); float s2 = 0.f;
#pragma unroll
    for (int j = 0; j < 16; ++j) { const f32x4 d = v[j] - mean; s2 += (d.x * d.x + d.y * d.y) + (d.z * d.z + d.w * d.w); }
    rstd = 1.f / sqrtf(wave_sum(s2) * (1.f / DM) + LN_EPS);
}
__device__ __forceinline__ int row_batch(int m) { return m < SEQ_P ? 0 : 1 + ((m - SEQ_P) >> 12); }
__device__ __forceinline__ f32x4 ldg4(const float* base, unsigned off) { return *(const GAS f32x4*)((const GAS char*)base + off); }
__device__ __forceinline__ void stg4(float* base, unsigned off, f32x4 v) { *(GAS f32x4*)((GAS char*)base + off) = v; }
__device__ __forceinline__ void stg1(void* base, unsigned off, unsigned v) { *(GAS unsigned*)((GAS char*)base + off) = v; }
__device__ __forceinline__ void phase1(Frame& F) {
    const int gw = F.vcu * NWAVES + F.wave, NGW = F.G * NWAVES; const unsigned lo = (unsigned)F.lane * 16u;
    for (int m = gw; m < M; m += NGW) {
        const float* xrow = m < SEQ_P ? F.xp + (size_t)m * DM : F.xs + (size_t)(m - SEQ_P) * DM;
        const float* md = F.mod + (size_t)row_batch(m) * NMOD * DM;
        f32x4 v[16];
#pragma unroll
        for (int j = 0; j < 16; ++j) v[j] = ldg4(xrow, lo + 1024u * j);
        float mean, rstd; row_stats(v, mean, rstd);
        unsigned char* orow = (unsigned char*)F.H + (size_t)m * DM; constexpr float SC = (float)(1 << L_H1);
#pragma unroll
        for (int j = 0; j < 16; ++j) { const f32x4 sh = ldg4(md, lo + 1024u * j), scl = ldg4(md + DM, lo + 1024u * j);
            const f32x4 y = ((v[j] - mean) * rstd * (scl + 1.0f) + sh) * SC; stg1(orow, (unsigned)F.lane * 4u + 256u * j, pk4_fp8(y.x, y.y, y.z, y.w)); }
    }
}
__device__ __forceinline__ void phase4(Frame& F, char* lds) {
    for (int idx = F.vcu; idx < 1536; idx += F.G) {
        const bool pr = idx < 512; const int u = pr ? idx : idx - 512;
        const int head = pr ? u >> 5 : (u >> 4) & 15, qb = pr ? u & 31 : u & 15; const size_t row0 = pr ? 0 : SEQ_P + (size_t)(u >> 8) * SEQ_S;
        att8::attn_a8<0>(F.QA8 + (row0 + qb * 256) * 2048 + head * HD, F.KA8 + row0 * 512 + (head >> 2) * HD, F.VT8 + ((row0 >> 6) * 4 + (head >> 2)) * (size_t)att8::TB,
            (unsigned char*)F.Y + (row0 + qb * 256) * DM + head * HD, pr ? SEQ_P / 64 : SEQ_S / 64, lds, 0, 0.f, 0.f); }
    for (int u = F.vcu; u < 1536; u += F.G) { const int pm = u >> 4, head = u & 15;
        const int T = pm < 32 ? SEQ_P : SEQ_S, qb = pm < 32 ? pm : (pm - 32) & 15; const size_t row0 = pm < 32 ? 0 : SEQ_P + (size_t)((pm - 32) >> 4) * SEQ_S;
        const int q0 = qb * 256, ks = q0 >= 128 ? q0 - 128 : 0, ke = q0 + 384 <= T ? q0 + 384 : T;
        const float slope = __builtin_amdgcn_exp2f(-0.5f * (float)(head + 1));
        const size_t kr0 = row0 + ks; att8::attn_a8<1>(F.QB8 + (row0 + q0) * 2048 + head * HD, F.KB8 + kr0 * 512 + (head >> 2) * HD, F.VTB8 + ((kr0 >> 6) * 4 + (head >> 2)) * (size_t)att8::TB,
            (unsigned char*)F.Y + (row0 + q0) * DM + 2048 + head * HD, (ke - ks) / 64, lds, q0 - ks, slope * 1.4426950408889634f, F.sink[head] * 1.4426950408889634f); }
}
__device__ __forceinline__ void ld_row_h(const unsigned short* row, unsigned lane, f32x4 (&v)[16]) {
#pragma unroll
    for (int j = 0; j < 8; ++j) { const v4u hv = *(const GAS v4u*)((const GAS char*)row + lane * 16u + 1024u * j);
        v[2 * j] = (f32x4){h_lo(hv.x), h_hi(hv.x), h_lo(hv.y), h_hi(hv.y)}; v[2 * j + 1] = (f32x4){h_lo(hv.z), h_hi(hv.z), h_lo(hv.w), h_hi(hv.w)}; }
}
__device__ __forceinline__ void phase7(Frame& F) {
    const int gw = F.vcu * NWAVES + F.wave, NGW = F.G * NWAVES; const unsigned ln = (unsigned)F.lane, lo = ln * 32u;
    for (int m = gw; m < M; m += NGW) {
        const float* md = F.mod + (size_t)row_batch(m) * NMOD * DM;
        f32x4 v[16]; ld_row_h((const unsigned short*)F.P + (size_t)m * DM, ln, v);
        float mean, rstd; row_stats(v, mean, rstd);
        unsigned short* xrow = (unsigned short*)F.H + (size_t)m * DM;
#pragma unroll
        for (int j = 0; j < 8; ++j) {
#pragma unroll
            for (int h = 0; h < 2; ++h) { const f32x4 g = ldg4(F.ln1g, lo + 2048u * j + 16u * h), b = ldg4(F.ln1b, lo + 2048u * j + 16u * h); v[2 * j + h] = (v[2 * j + h] - mean) * rstd * g + b; }
            v4u w; w.x = pk_h2(v[2 * j].x, v[2 * j].y); w.y = pk_h2(v[2 * j].z, v[2 * j].w); w.z = pk_h2(v[2 * j + 1].x, v[2 * j + 1].y); w.w = pk_h2(v[2 * j + 1].z, v[2 * j + 1].w);
            *(GAS v4u*)((GAS char*)xrow + ln * 16u + 1024u * j) = w;
            v[2 * j] = (f32x4){h_lo(w.x), h_hi(w.x), h_lo(w.y), h_hi(w.y)}; v[2 * j + 1] = (f32x4){h_lo(w.z), h_hi(w.z), h_lo(w.w), h_hi(w.w)}; }
        row_stats(v, mean, rstd);
        float amax = 0.f;
#pragma unroll
        for (int j = 0; j < 16; ++j) { const f32x4 sh = ldg4(md + 3 * DM, lo + 2048u * (j >> 1) + 16u * (j & 1)), scl = ldg4(md + 4 * DM, lo + 2048u * (j >> 1) + 16u * (j & 1));
            v[j] = (v[j] - mean) * rstd * (scl + 1.0f) + sh; amax = fmaxf(amax, fmaxf(fmaxf(fabsf(v[j].x), fabsf(v[j].y)), fmaxf(fabsf(v[j].z), fabsf(v[j].w)))); }
#pragma unroll
        for (int o = 1; o < 64; o <<= 1) amax = fmaxf(amax, __shfl_xor(amax, o));
        const float inv = amax > 0.f ? 127.0f / amax : 0.f;
        if (F.lane == 0) F.rsc[m] = amax * (1.0f / 127.0f);
        unsigned char* orow = (unsigned char*)F.Y + (size_t)m * DM;
#pragma unroll
        for (int j = 0; j < 8; ++j) { unsigned q[2];
#pragma unroll
            for (int h = 0; h < 2; ++h) { const f32x4 y = v[2 * j + h]; const int q0 = (int)__builtin_rintf(y.x * inv) & 0xff, q1 = (int)__builtin_rintf(y.y * inv) & 0xff, q2 = (int)__builtin_rintf(y.z * inv) & 0xff, q3 = (int)__builtin_rintf(y.w * inv) & 0xff;
                q[h] = (unsigned)(q0 | (q1 << 8) | (q2 << 16) | (q3 << 24)); }
            *(GAS v2u*)((GAS char*)orow + ln * 8u + 512u * j) = (v2u){q[0], q[1]}; }
    }
}
__device__ __forceinline__ void phase10(Frame& F) {
    const int gw = F.vcu * NWAVES + F.wave, NGW = F.G * NWAVES; const unsigned ln = (unsigned)F.lane, lo = ln * 32u;
    for (int m = gw; m < M; m += NGW) {
        f32x4 v[16]; ld_row_h((const unsigned short*)F.H + (size_t)m * DM, ln, v);
        float mean, rstd; row_stats(v, mean, rstd);
        float* orow = F.out + (size_t)m * DM;
#pragma unroll
        for (int j = 0; j < 16; ++j) { const unsigned off = lo + 2048u * (j >> 1) + 16u * (j & 1); const f32x4 g = ldg4(F.ln2g, off), b = ldg4(F.ln2b, off); stg4(orow, off, (v[j] - mean) * rstd * g + b); }
    }
}

__global__ void __launch_bounds__(NWAVES * 64, 2) enc_fwd(Args args) {
    extern __shared__ __attribute__((aligned(16))) unsigned char lds[];
    Frame F;
    F.lds = (LAS unsigned char*)lds;
    F.tid = threadIdx.x; F.lane = F.tid & 63; F.wave = __builtin_amdgcn_readfirstlane(F.tid >> 6);
    F.G = gridDim.x; { const int bx = blockIdx.x; F.vcu = (F.G % 8 == 0) ? (bx % 8) * (F.G / 8) + bx / 8 : bx; }
    gu32* ctl = (gu32*)(args.ws + WS_CTL);
    volatile LAS unsigned* MISC = (volatile LAS unsigned*)(F.lds + MISC_OFF);
    for (int u = F.tid; u < (LDS_BYTES - LDSCTL_OFF) / 4; u += NWAVES * 64) ((LAS unsigned*)(F.lds + LDSCTL_OFF))[u] = 0u;
    __syncthreads();
    XcdBarrier bar; bar.bar = (unsigned*)(ctl + CW_BAR); bar.x = 0; bar.st = nullptr;
    if (N_LAUNCHES == 1) bar = xcd_barrier_post((unsigned*)(ctl + CW_BAR), MISC + 8);
    const int lo = args.ph_lo, hi = args.ph_hi;
#ifndef PH_MASK
#define PH_MASK 0x7ff
#endif
#define IN(k) (((PH_MASK >> (k)) & 1) && lo <= (k) && (k) < hi)
#define SEAM(k) do { if (IN(k) && IN((k) + 1)) xcd_barrier(bar); } while (0)
#ifndef REP_PHASE
#define REP_PHASE -1
#endif
#define REPS(k) ((k) == REP_PHASE ? 2 : 1)
    if (IN(0)) for (int rep = 0; rep < REPS(0); ++rep) { if (rep) xcd_barrier(bar); frame_ptrs(F); phase0(F); } SEAM(0);
    if (IN(1)) for (int rep = 0; rep < REPS(1); ++rep) { if (rep) xcd_barrier(bar); frame_ptrs(F); phase1(F); } SEAM(1);
    if (IN(2)) for (int rep = 0; rep < REPS(2); ++rep) { if (rep) xcd_barrier(bar); frame_ptrs(F); if ((F.vcu & 1) == 0) { side2(F); __syncthreads(); frame_ptrs(F); } pg8::Gemm g{F.H, F.Win_t, DM, DM, DM, 0, e8m0x4(L_H1), e8m0x4(L_WIN)}; pg8::EpiProj E{F.P, F.qn, F.kn, F.rope, (LAS float*)(F.lds + LDSCTL_OFF + 1024), F.QA8, F.KA8, F.VT8, F.QB8, F.KB8, F.VTB8};
#if defined(KDOUBLE_PHASE) && KDOUBLE_PHASE == 2
        pg8::PairedOrder S; S.init(M, IN_W, F.G, (int)blockIdx.x); pg8::EpiHalf<pg8::EpiProj, false> E2{E}; pg8::gemm_phase<pg8::EpiHalf<pg8::EpiProj, false>, pg8::PairedOrder, 1>(F.lds, g, S, E2); }
#else
        pg8::StaticOrder S; S.init(M, IN_W, F.G, (int)blockIdx.x); pg8::gemm_phase<pg8::EpiProj, pg8::StaticOrder, 1>(F.lds, g, S, E); }
#endif
        if (IN(2) && (F.vcu & 1)) { frame_ptrs(F); side2(F); }
        SEAM(2);
    if (IN(4)) for (int rep = 0; rep < REPS(4); ++rep) { if (rep) xcd_barrier(bar); frame_ptrs(F); if ((F.vcu & 1) == 0) { side4(F); __syncthreads(); frame_ptrs(F); } phase4(F, (char*)lds); __syncthreads(); if (F.vcu & 1) { frame_ptrs(F); side4(F); } } SEAM(4);
    if (IN(5)) for (int rep = 0; rep < REPS(5); ++rep) { if (rep) xcd_barrier(bar); frame_ptrs(F); pg8::Gemm g{F.Y, F.Wbr_t, DM, DM, 2048, 2048, e8m0x4(L_Y), e8m0x4(L_WBR)}; pg8::PairedOrder S; S.init(M, DM, F.G, (int)blockIdx.x); pg8::EpiMerge E{F.P, (unsigned char*)F.H};
        pg8::gemm_phase<pg8::EpiMerge, pg8::PairedOrder, 1>(F.lds, g, S, E); } SEAM(5);
    if (IN(6)) for (int rep = 0; rep < REPS(6); ++rep) { if (rep) xcd_barrier(bar); frame_ptrs(F); pg8::Gemm g{F.H, F.Wo_t, DM, DM, DM, 0, e8m0x4(L_MG), e8m0x4(L_WO)}; pg8::StaticOrder S; S.init(M, DM, F.G, (int)blockIdx.x); pg8::EpiRes<false> E{F.xp, F.xs, nullptr, (unsigned short*)F.P, F.mod + 2 * DM};
        pg8::gemm_phase<pg8::EpiRes<false>, pg8::StaticOrder, 1>(F.lds, g, S, E); } SEAM(6);
    if (IN(7)) { frame_ptrs(F); phase7(F); } SEAM(7);
    if (IN(8)) for (int rep = 0; rep < REPS(8); ++rep) { if (rep) xcd_barrier(bar); frame_ptrs(F); pg8::Gemm g{F.Y, F.Wgu_t, DM, DM, DM, 0, 0, 0}; pg8::EpiSwiglu E{F.P, F.rsc, F.csc};
#if defined(KDOUBLE_PHASE) && KDOUBLE_PHASE == 8
        pg8::PairedOrder S; S.init(M, 2 * DFF, F.G, (int)blockIdx.x); pg8::EpiHalf<pg8::EpiSwiglu, true> E2{E}; pg8::gemm_phase<pg8::EpiHalf<pg8::EpiSwiglu, true>, pg8::PairedOrder, 2>(F.lds, g, S, E2); }
#else
        pg8::StaticOrder S; S.init(M, 2 * DFF, F.G, (int)blockIdx.x); pg8::gemm_phase<pg8::EpiSwiglu, pg8::StaticOrder, 2>(F.lds, g, S, E); }
#endif
        SEAM(8);
    if (IN(9)) { frame_ptrs(F); pg8::Gemm g{F.P, F.Wd_t, 2 * DFF, 2 * DFF, 2 * DFF, 0, 0, 0}; pg8::StaticOrder S; S.init(M, DM, F.G, (int)blockIdx.x, 2); pg8::EpiRes<true> E{nullptr, nullptr, (const unsigned short*)F.H, (unsigned short*)F.H, F.mod + 5 * DM};
        pg8::gemm_phase<pg8::EpiRes<true>, pg8::StaticOrder, 0>(F.lds, g, S, E); } SEAM(9);
    if (IN(10)) { frame_ptrs(F); phase10(F); }
#undef IN
#undef SEAM
}

extern "C" void kernel_launch(void* const* d_in, const int* in_sizes, int n_in, void* d_out, int out_size, void* d_ws, size_t ws_size, hipStream_t stream) {
    static int grid = 0;
    if (grid == 0) {
        if (n_in != 20 || in_sizes[0] != SEQ_P * DM || out_size != M * DM || ws_size < WS_END) {
            fprintf(stderr, "kernel_launch: shape mismatch: n_in %d in0 %d out %d ws %zu (need %zu)\n", n_in, n_in > 0 ? in_sizes[0] : -1, out_size, ws_size, (size_t)WS_END); grid = -1; return; }
        int dev = 0, cus = 0, per_cu = 0;
        if (hipGetDevice(&dev) != hipSuccess || hipDeviceGetAttribute(&cus, hipDeviceAttributeMultiprocessorCount, dev) != hipSuccess) { grid = -1; return; }
        if (hipFuncSetAttribute((const void*)enc_fwd, hipFuncAttributeMaxDynamicSharedMemorySize, LDS_BYTES) != hipSuccess) { fprintf(stderr, "kernel_launch: hipFuncSetAttribute failed\n"); grid = -1; return; }
        if (hipOccupancyMaxActiveBlocksPerMultiprocessor(&per_cu, (const void*)enc_fwd, NWAVES * 64, LDS_BYTES) != hipSuccess || per_cu < 1) { fprintf(stderr, "kernel_launch: occupancy query says %d\n", per_cu); (void)hipGetLastError(); grid = -1; return; }
        grid = cus;
    }
    if (grid < 0) return;
    (void)hipMemsetAsync((char*)d_ws + WS_CTL, 0, CTL_ZERO_BYTES, stream);
    Args a{};
    for (int i = 0; i < 20; ++i) a.in[i] = (const float*)d_in[i];
    a.out = (float*)d_out; a.ws = (unsigned char*)d_ws;
    if (N_LAUNCHES == 1) { a.ph_lo = 0; a.ph_hi = N_PHASES; hipLaunchKernelGGL(enc_fwd, dim3(grid), dim3(NWAVES * 64), LDS_BYTES, stream, a); }
    else for (int li = 0; li < N_PHASES; ++li) { a.ph_lo = li; a.ph_hi = li + 1; hipLaunchKernelGGL(enc_fwd, dim3(grid), dim3(NWAVES * 64), LDS_BYTES, stream, a); }
    const hipError_t le = hipPeekAtLastError();
    if (le != hipSuccess) fprintf(stderr, "kernel_launch: launch failed: %s\n", hipGetErrorName(le));
}
```

```cpp
#include <hip/hip_runtime.h>
#include <hip/hip_bf16.h>
#include <cstdio>
#include <cstdint>

#ifndef MK_N_LAUNCHES
#define MK_N_LAUNCHES 1
#endif
constexpr int N_PHASES = 11;
constexpr int N_LAUNCHES = MK_N_LAUNCHES;
constexpr int NWAVES = 8;

constexpr int DM = 4096, SEQ_P = 8192, SEQ_S = 4096, NB_S = 4, NBATCH = 5;
constexpr int M = SEQ_P + NB_S * SEQ_S;
constexpr int HD = 128, NHA = 16, NKVA = 4, NHB = 16, NKVB = 4;
constexpr int C_QA = 0, C_KA = 2048, C_VA = 2560, C_QB = 3072, C_KB = 5120, C_VB = 5632, C_GA = 6144, C_GB = 10240, IN_W = 14336;
constexpr int DFF = 11008, NMOD = 6;
constexpr int GATE_B0 = C_GA * 2;
constexpr float ALPHA = 1.189207115002721f, LN_EPS = 1e-5f, RMS_EPS = 1e-6f;
constexpr float ATT_SCALE = 0.088388347648318440f;
constexpr int L_H1 = 3, L_WIN = 9, L_Y = 5, L_WBR = 9, L_MG = 6, L_WO = 10, L_QK = 4;
constexpr float Q_PRE = ATT_SCALE * 1.4426950408889634f * 8.f;
constexpr int e8m0x4(int L) { return (127 - L) * 0x01010101; }

constexpr size_t MiB = 1u << 20;
constexpr size_t WS_CTL = 0, CTL_ZERO_BYTES = 1 * MiB;
constexpr size_t WS_MOD = 1 * MiB;
constexpr size_t WS_ROPE = 1 * MiB + 512 * 1024;
constexpr size_t WS_RSC = 1 * MiB + 640 * 1024;
constexpr size_t WS_CSC = 1 * MiB + 768 * 1024;
constexpr int CW_CMAX = 16384;
constexpr size_t WS_WIN = 2 * MiB;
constexpr size_t WS_WBR = WS_WIN + 112 * MiB;
constexpr size_t WS_WO = WS_WBR + 32 * MiB;
constexpr size_t WS_WGU = WS_WO + 32 * MiB;
constexpr size_t WS_WD = WS_WGU + 172 * MiB;
constexpr size_t WS_H = WS_WD + 86 * MiB;
constexpr size_t WS_Y = WS_H + 192 * MiB;
constexpr size_t WS_P = WS_Y + 96 * MiB;
constexpr size_t WS_QA8 = WS_P + 672 * MiB;
constexpr size_t WS_KA8 = WS_QA8 + 48 * MiB;
constexpr size_t WS_VT8 = WS_KA8 + 12 * MiB;
constexpr size_t WS_QB8 = WS_VT8 + 12 * MiB, WS_KB8 = WS_QB8 + 48 * MiB, WS_VTB8 = WS_KB8 + 12 * MiB;
constexpr size_t WS_END = WS_VTB8 + 12 * MiB;
static_assert((size_t)IN_W * DM * 2 <= 112 * MiB && (size_t)2 * DFF * DM * 2 <= 172 * MiB && (size_t)DM * DFF * 2 <= 86 * MiB && (size_t)M * IN_W * 2 <= 672 * MiB, "ws map");
constexpr int CW_TMO = 0, CW_BAR = 4096;

constexpr int RING_BYTES = 131072, LDSCTL_OFF = RING_BYTES, MISC_OFF = LDSCTL_OFF + 320, LDS_BYTES = 147456;

#define GAS __attribute__((address_space(1)))
#define LAS __attribute__((address_space(3)))
typedef unsigned short bf16;
typedef unsigned v4u __attribute__((ext_vector_type(4)));
typedef unsigned v2u __attribute__((ext_vector_type(2)));
typedef float f32x4 __attribute__((ext_vector_type(4)));
typedef float f32x2 __attribute__((ext_vector_type(2)));
typedef float f32x16 __attribute__((ext_vector_type(16)));
typedef short bf16x8 __attribute__((ext_vector_type(8)));
typedef short s16x4 __attribute__((ext_vector_type(4)));
typedef GAS unsigned gu32;
#define RLX_AGENT __ATOMIC_RELAXED, __HIP_MEMORY_SCOPE_AGENT
#define LDS_WAIT() asm volatile("s_waitcnt lgkmcnt(0)" ::: "memory")
#define VM_WAIT() asm volatile("s_waitcnt vmcnt(0)" ::: "memory")
__device__ __forceinline__ unsigned cvt_pk_bf16(float lo, float hi) { unsigned r; asm volatile("v_cvt_pk_bf16_f32 %0, %1, %2" : "=v"(r) : "v"(lo), "v"(hi)); return r; }
__device__ __forceinline__ float clamp448(float x) { return __builtin_amdgcn_fmed3f(x, -448.f, 448.f); }
__device__ __forceinline__ unsigned pk4_fp8(float a, float b, float c, float d) {
    int w = 0; w = __builtin_amdgcn_cvt_pk_fp8_f32(clamp448(a), clamp448(b), w, false); w = __builtin_amdgcn_cvt_pk_fp8_f32(clamp448(c), clamp448(d), w, true); return (unsigned)w; }
typedef _Float16 h16x2 __attribute__((ext_vector_type(2)));
__device__ __forceinline__ unsigned pk_h2(float a, float b) { const h16x2 h = {(_Float16)a, (_Float16)b}; return __builtin_bit_cast(unsigned, h); }
__device__ __forceinline__ float h_lo(unsigned w) { return (float)__builtin_bit_cast(h16x2, w)[0]; }
__device__ __forceinline__ float h_hi(unsigned w) { return (float)__builtin_bit_cast(h16x2, w)[1]; }
__device__ __forceinline__ unsigned pk4_gate(float a, float b, float c, float d) { unsigned w = 0;
    w = __builtin_amdgcn_cvt_pk_u8_f32(a * 256.f - 0.5f, 0, w); w = __builtin_amdgcn_cvt_pk_u8_f32(b * 256.f - 0.5f, 1, w); w = __builtin_amdgcn_cvt_pk_u8_f32(c * 256.f - 0.5f, 2, w); w = __builtin_amdgcn_cvt_pk_u8_f32(d * 256.f - 0.5f, 3, w); return w; }
template <int K> __device__ __forceinline__ float gate_f(unsigned w) { const float q = (float)((w >> (8 * K)) & 0xffu);
    return q * (1.f / 256.f) + (1.f / 512.f); }
__device__ __forceinline__ float bf_lo(unsigned w) { return __uint_as_float(w << 16); }
__device__ __forceinline__ float bf_hi(unsigned w) { return __uint_as_float(w & 0xffff0000u); }
__device__ __forceinline__ float sigmoidf_(float x) { return __builtin_amdgcn_rcpf(1.0f + __builtin_amdgcn_exp2f(-1.4426950408889634f * x)); }

__device__ __forceinline__ int kpos(int kappa) { const int k5 = kappa & 31; return 32 * ((k5 >> 2) & 1) + 16 * (kappa >> 5) + (k5 & 3) + 4 * (k5 >> 3); }
__device__ __forceinline__ int tid_fresh() { int t = threadIdx.x; asm volatile("" : "+v"(t)); return t; }

namespace pg8 {
constexpr int BM = 256, BK = 64, HALF = 128, HTB = HALF * BK * 2, STAGE_BYTES = 8 * HTB, NXCD = 8, WGM = 8;
__host__ __device__ __forceinline__ int lds_byte(int r, int c) { const int st = (r >> 4) * 2 + (c >> 5), rr = r & 15, cc = c & 31, ob = rr * 64 + cc * 2; return st * 1024 + (ob ^ (((ob >> 9) & 1) << 5)); }
__host__ __device__ __forceinline__ void stage_rc(int b, int& R, int& C) { const int st = b / 1024, sb = b % 1024, swz = sb ^ (((sb >> 9) & 1) << 5); R = (st >> 1) * 16 + swz / 64; C = (st & 1) * 32 + (swz % 64) / 2; }
__host__ __device__ __forceinline__ int perm32(int rho) { const int n = rho >> 4, i = rho & 15; return 8 * (i >> 2) + 4 * n + (i & 3); }

struct Unit { int pm, pn, kh; };
struct Gemm { const void* A; const void* Bt; int lda, ldb, kbytes, khoff; int sa, sb; };

struct StaticOrder {
    int nM, nN, nwg, G, c, wgm;
    __device__ void init(int M_, int N_, int G_, int c_, int wgm_ = WGM) { nM = M_ / BM; nN = N_ / BM; nwg = nM * nN; G = G_; c = c_; wgm = wgm_; }
    __device__ bool tile(int i, Unit& u) const {
        const long L = (long)i * G + c; if (L >= nwg) return false;
        int wgid = (int)L; { const int q = nwg / NXCD, r = nwg % NXCD, xcd = wgid % NXCD, off = wgid / NXCD; wgid = (xcd < r ? xcd * (q + 1) : r * (q + 1) + (xcd - r) * q) + off; }
        const int nig = wgm * nN, gid = wgid / nig, fm = gid * wgm, gsz = (nM - fm) < wgm ? (nM - fm) : wgm;
        u.pm = fm + ((wgid % nig) % gsz); u.pn = (wgid % nig) / gsz; u.kh = 0; return true;
    }
    __device__ bool next(int i, Unit& u) const { return tile(i, u); }
};
struct PairedOrder : StaticOrder {
    __device__ bool next(int i, Unit& u) const { const bool ok = tile(i >> 1, u); u.kh = i & 1; return ok; }
};

typedef f32x4 Acc[2][2][4][2];
typedef int v4i __attribute__((ext_vector_type(4)));
typedef int v8i __attribute__((ext_vector_type(8)));

struct EpiProj {
    static constexpr bool PERM = true, PAIRED = false;
    bf16* O; const float* qn; const float* kn; const float* rope; LAS float* xs;
    unsigned char* qa8; unsigned char* ka8; unsigned char* vt8; unsigned char* qb8; unsigned char* kb8; unsigned char* vtb8;
    __device__ __forceinline__ void operator()(const Acc& acc, const Unit& u, int wr, int wc, int fr, int fq) const {
        const int row0 = u.pm * BM + wr * 64 + fr;
        if (u.pn < 10) {
            const int p = wc >> 1, i0 = 16 * (wc & 1) + 4 * fq; const float* gn = (u.pn < 8 ? qn : kn) + 64 * p + i0;
            const f32x4 g1 = *(const f32x4*)gn, g2 = *(const f32x4*)(gn + 32);
#pragma unroll
            for (int ai = 0; ai < 2; ++ai)
#pragma unroll
                for (int m = 0; m < 4; ++m)
#pragma unroll
                    for (int bj = 0; bj < 2; ++bj) { const f32x4 v0 = acc[ai][bj][m][0], v1 = acc[ai][bj][m][1];
                        float ss = (v0[0] * v0[0] + v0[1] * v0[1]) + (v0[2] * v0[2] + v0[3] * v0[3]) + (v1[0] * v1[0] + v1[1] * v1[1]) + (v1[2] * v1[2] + v1[3] * v1[3]);
                        ss += __shfl_xor(ss, 16); ss += __shfl_xor(ss, 32);
                        if (fq == 0) xs[((ai * HALF + wr * 64 + m * 16 + fr) * 2 + bj) * 4 + wc] = ss; }
            asm volatile("s_waitcnt lgkmcnt(0)" ::: "memory"); __builtin_amdgcn_s_barrier(); asm volatile("" ::: "memory");
            const float* tab = rope + (p ? 8192 : 0); const int sin_off = p ? 2048 : 4096;
#pragma unroll
            for (int ai = 0; ai < 2; ++ai)
#pragma unroll
                for (int m = 0; m < 4; ++m) { const int r = row0 + ai * HALF + m * 16; const int t = r < SEQ_P ? r : (r - SEQ_P) & (SEQ_S - 1);
                    const float* tp = tab + (p ? (t & 63) : (t >> 6)) * 32 + i0; const f32x4 cs = *(const f32x4*)tp, sn = *(const f32x4*)(tp + sin_off);
#pragma unroll
                    for (int bj = 0; bj < 2; ++bj) { unsigned char* dst = (u.pn < 8 ? qa8 + (size_t)r * 2048 + (2 * u.pn + bj) * HD : ka8 + (size_t)r * 512 + (2 * (u.pn - 8) + bj) * HD) + 64 * p + i0; const f32x4 q4 = *(const LAS f32x4*)(xs + ((ai * HALF + wr * 64 + m * 16 + fr) * 2 + bj) * 4);
                        const float rs = 1.0f / sqrtf(((q4[0] + q4[1]) + (q4[2] + q4[3])) * (1.0f / HD) + RMS_EPS);
                        const f32x4 x1 = acc[ai][bj][m][0] * rs * g1, x2 = acc[ai][bj][m][1] * rs * g2;
                        const f32x4 y1 = x1 * cs - x2 * sn, y2 = x2 * cs + x1 * sn;
                        const float SC = (float)(1 << L_QK) * (u.pn < 8 ? Q_PRE : 1.0f);
                        *(unsigned*)dst = pk4_fp8(y1[0] * SC, y1[1] * SC, y1[2] * SC, y1[3] * SC); *(unsigned*)(dst + 32) = pk4_fp8(y2[0] * SC, y2[1] * SC, y2[2] * SC, y2[3] * SC); } }
            return;
        }
        if (u.pn == 10 || u.pn == 11 || u.pn == 22 || u.pn == 23) {
            unsigned char* const vt = u.pn < 12 ? vt8 : vtb8; const int h0 = 2 * (u.pn < 12 ? u.pn - 10 : u.pn - 22);
            constexpr float SC = (float)(1 << L_QK);
#pragma unroll
            for (int ai = 0; ai < 2; ++ai)
#pragma unroll
                for (int m = 0; m < 4; ++m) { const int r = row0 + ai * HALF + m * 16; const int gb = r >> 6, pos = kpos(r & 63);
#pragma unroll
                    for (int bj = 0; bj < 2; ++bj) { unsigned char* vb = vt + ((size_t)(gb * 4 + h0 + bj) * HD + wc * 32 + 8 * fq) * 64 + pos;
                        const f32x4 v0 = acc[ai][bj][m][0] * SC, v1 = acc[ai][bj][m][1] * SC; const unsigned w0 = pk4_fp8(v0[0], v0[1], v0[2], v0[3]), w1 = pk4_fp8(v1[0], v1[1], v1[2], v1[3]);
#pragma unroll
                        for (int e = 0; e < 4; ++e) { vb[e * 64] = (unsigned char)(w0 >> (8 * e)); vb[(4 + e) * 64] = (unsigned char)(w1 >> (8 * e)); } } }
            return;
        }
        const int col0 = u.pn * BM + wc * 32 + 8 * fq; const bool sig = u.pn * BM >= C_GA;
        if (!sig) {
            const bool isq = u.pn < 20; const float SC = (float)(1 << L_QK) * (isq ? Q_PRE : 1.0f);
#pragma unroll
            for (int ai = 0; ai < 2; ++ai)
#pragma unroll
                for (int m = 0; m < 4; ++m) { const size_t r = (size_t)(row0 + ai * HALF + m * 16);
                    unsigned char* dst = isq ? qb8 + r * 2048 + (col0 - C_QB) : kb8 + r * 512 + (col0 - C_KB);
#pragma unroll
                    for (int bj = 0; bj < 2; ++bj) { const f32x4 v0 = acc[ai][bj][m][0] * SC, v1 = acc[ai][bj][m][1] * SC;
                        v2u w; w.x = pk4_fp8(v0[0], v0[1], v0[2], v0[3]); w.y = pk4_fp8(v1[0], v1[1], v1[2], v1[3]); *(v2u*)(dst + bj * HALF) = w; } }
            return;
        }
#pragma unroll
        for (int ai = 0; ai < 2; ++ai)
#pragma unroll
            for (int m = 0; m < 4; ++m) { bf16* rowp = O + (size_t)(row0 + ai * HALF + m * 16) * IN_W + col0;
#pragma unroll
                for (int bj = 0; bj < 2; ++bj) { f32x4 v0 = acc[ai][bj][m][0], v1 = acc[ai][bj][m][1];
                    if (sig) {
#pragma unroll
                        for (int e = 0; e < 4; ++e) { v0[e] = sigmoidf_(v0[e]); v1[e] = sigmoidf_(v1[e]); }
                        v2u g; g.x = pk4_gate(v0[0], v0[1], v0[2], v0[3]); g.y = pk4_gate(v1[0], v1[1], v1[2], v1[3]);
                        *(v2u*)((unsigned char*)(rowp - col0) + GATE_B0 + (col0 - C_GA) + bj * HALF) = g; }
                    else { v4u w; w.x = cvt_pk_bf16(v0[0], v0[1]); w.y = cvt_pk_bf16(v0[2], v0[3]); w.z = cvt_pk_bf16(v1[0], v1[1]); w.w = cvt_pk_bf16(v1[2], v1[3]);
                        *(v4u*)(rowp + bj * HALF) = w; } } }
    }
};
struct EpiMerge {
    static constexpr bool PERM = true, PAIRED = true;
    const bf16* P; unsigned char* O;
    __device__ __forceinline__ void mid(Acc& acc, const Unit& u, int wr, int wc, int fr, int fq) const {
        const int row0 = u.pm * BM + wr * 64 + fr, col0 = u.pn * BM + wc * 32 + 8 * fq;
#pragma unroll
        for (int ai = 0; ai < 2; ++ai)
#pragma unroll
            for (int m = 0; m < 4; ++m) { const unsigned char* gp = (const unsigned char*)(P + (size_t)(row0 + ai * HALF + m * 16) * IN_W) + GATE_B0 + col0;
#pragma unroll
                for (int bj = 0; bj < 2; ++bj) { const v2u a = *(const v2u*)(gp + bj * HALF), b = *(const v2u*)(gp + DM + bj * HALF);
#define GM_(n, e, AW, BW, K) acc[ai][bj][m][n][e] *= gate_f<K>(AW) * __builtin_amdgcn_rcpf(gate_f<K>(BW))
                    GM_(0, 0, a.x, b.x, 0); GM_(0, 1, a.x, b.x, 1); GM_(0, 2, a.x, b.x, 2); GM_(0, 3, a.x, b.x, 3); GM_(1, 0, a.y, b.y, 0); GM_(1, 1, a.y, b.y, 1); GM_(1, 2, a.y, b.y, 2); GM_(1, 3, a.y, b.y, 3);
#undef GM_
                } }
    }
    __device__ __forceinline__ void operator()(const Acc& acc, const Unit& u, int wr, int wc, int fr, int fq) const {
        const int row0 = u.pm * BM + wr * 64 + fr, col0 = u.pn * BM + wc * 32 + 8 * fq;
        v2u gb[2][4][2];
#pragma unroll
        for (int ai = 0; ai < 2; ++ai)
#pragma unroll
            for (int m = 0; m < 4; ++m) { const size_t r = (size_t)(row0 + ai * HALF + m * 16);
#pragma unroll
                for (int bj = 0; bj < 2; ++bj) gb[ai][m][bj] = *(const v2u*)((const unsigned char*)(P + r * IN_W) + GATE_B0 + DM + col0 + bj * HALF); }
        asm volatile("" ::: "memory");
#pragma unroll
        for (int ai = 0; ai < 2; ++ai)
#pragma unroll
            for (int m = 0; m < 4; ++m) { const size_t r = (size_t)(row0 + ai * HALF + m * 16);
#pragma unroll
                for (int bj = 0; bj < 2; ++bj) { const v2u b = gb[ai][m][bj];
                    const float s[8] = {gate_f<0>(b.x), gate_f<1>(b.x), gate_f<2>(b.x), gate_f<3>(b.x), gate_f<0>(b.y), gate_f<1>(b.y), gate_f<2>(b.y), gate_f<3>(b.y)};
                    const f32x4 v0 = acc[ai][bj][m][0], v1 = acc[ai][bj][m][1]; constexpr float SC = (float)(1 << L_MG);
                    v2u w; w.x = pk4_fp8(v0[0] * s[0] * SC, v0[1] * s[1] * SC, v0[2] * s[2] * SC, v0[3] * s[3] * SC); w.y = pk4_fp8(v1[0] * s[4] * SC, v1[1] * s[5] * SC, v1[2] * s[6] * SC, v1[3] * s[7] * SC);
                    *(v2u*)(O + r * DM + col0 + bj * HALF) = w; } }
    }
};
template <bool XH> struct EpiRes {
    static constexpr bool PERM = true, PAIRED = false;
    const float* xp; const float* xs; const unsigned short* xh; unsigned short* out; const float* gate;
    __device__ __forceinline__ void operator()(const Acc& acc, const Unit& u, int wr, int wc, int fr, int fq) const {
        const int row0 = u.pm * BM + wr * 64 + fr, col0 = u.pn * BM + wc * 32 + 8 * fq;
        const int b = u.pm < 32 ? 0 : 1 + ((u.pm - 32) >> 4);
        const float* xb = u.pm < 32 ? xp : xs - (size_t)SEQ_P * DM;
        const float* gp = gate + (size_t)b * NMOD * DM + col0;
        f32x4 gv[2][2];
#pragma unroll
        for (int bj = 0; bj < 2; ++bj)
#pragma unroll
            for (int n = 0; n < 2; ++n) gv[bj][n] = *(const f32x4*)(gp + bj * HALF + n * 4);
#pragma unroll
        for (int ai = 0; ai < 2; ++ai) {
            f32x4 xv[4][2][2]; v4u hv[4][2];
#pragma unroll
            for (int m = 0; m < 4; ++m) { const size_t off = (size_t)(row0 + ai * HALF + m * 16) * DM + col0;
#pragma unroll
                for (int bj = 0; bj < 2; ++bj) {
                    if constexpr (XH) hv[m][bj] = *(const v4u*)(xh + off + bj * HALF);
                    else { xv[m][bj][0] = *(const f32x4*)(xb + off + bj * HALF); xv[m][bj][1] = *(const f32x4*)(xb + off + bj * HALF + 4); } } }
            asm volatile("" ::: "memory");
#pragma unroll
            for (int m = 0; m < 4; ++m) { const size_t off = (size_t)(row0 + ai * HALF + m * 16) * DM + col0;
#pragma unroll
                for (int bj = 0; bj < 2; ++bj) { f32x4 x0, x1;
                    if constexpr (XH) { const v4u h = hv[m][bj]; x0 = (f32x4){h_lo(h.x), h_hi(h.x), h_lo(h.y), h_hi(h.y)}; x1 = (f32x4){h_lo(h.z), h_hi(h.z), h_lo(h.w), h_hi(h.w)}; }
                    else { x0 = xv[m][bj][0]; x1 = xv[m][bj][1]; }
                    const f32x4 t0 = x0 * ALPHA + gv[bj][0] * acc[ai][bj][m][0], t1 = x1 * ALPHA + gv[bj][1] * acc[ai][bj][m][1];
                    v4u w; w.x = pk_h2(t0[0], t0[1]); w.y = pk_h2(t0[2], t0[3]); w.z = pk_h2(t1[0], t1[1]); w.w = pk_h2(t1[2], t1[3]);
                    __builtin_nontemporal_store(w, (v4u*)(out + off + bj * HALF)); } }
            asm volatile("" ::: "memory");
        }
    }
};
struct EpiSwiglu {
    static constexpr bool PERM = true, PAIRED = false;
    bf16* O; const float* rs; const float* cs;
    __device__ __forceinline__ void operator()(const Acc& acc, const Unit& u, int wr, int wc, int fr, int fq) const {
        const int row0 = u.pm * BM + wr * 64 + fr, col0 = u.pn * HALF + wc * 32 + 8 * fq;
        const float* cp = cs + u.pn * BM + wc * 32 + 8 * fq;
        const f32x4 cg0 = *(const f32x4*)cp, cg1 = *(const f32x4*)(cp + 4), cu0 = *(const f32x4*)(cp + HALF), cu1 = *(const f32x4*)(cp + HALF + 4);
        float rsv[2][4];
#pragma unroll
        for (int ai = 0; ai < 2; ++ai)
#pragma unroll
            for (int m = 0; m < 4; ++m) rsv[ai][m] = rs[row0 + ai * HALF + m * 16];
        asm volatile("" ::: "memory");
#pragma unroll
        for (int ai = 0; ai < 2; ++ai)
#pragma unroll
            for (int m = 0; m < 4; ++m) { float v[8]; const int r = row0 + ai * HALF + m * 16; const float rsc = rsv[ai][m];
#pragma unroll
                for (int n = 0; n < 2; ++n)
#pragma unroll
                    for (int e = 0; e < 4; ++e) { const float g = (float)__float_as_int(acc[ai][0][m][n][e]) * (rsc * (n ? cg1[e] : cg0[e])), up = (float)__float_as_int(acc[ai][1][m][n][e]) * (rsc * (n ? cu1[e] : cu0[e])); v[n * 4 + e] = g * sigmoidf_(g) * up; }
                v4u w; w.x = cvt_pk_bf16(v[0], v[1]); w.y = cvt_pk_bf16(v[2], v[3]); w.z = cvt_pk_bf16(v[4], v[5]); w.w = cvt_pk_bf16(v[6], v[7]);
                __builtin_nontemporal_store(w, (v4u*)(O + (size_t)r * DFF + col0)); }
    }
};

template <class Epi, bool INT> struct EpiHalf {
    static constexpr bool PERM = Epi::PERM, PAIRED = true; Epi e;
    __device__ __forceinline__ void mid(Acc&, const Unit&, int, int, int, int) const {}
    __device__ __forceinline__ void operator()(Acc& acc, const Unit& u, int wr, int wc, int fr, int fq) const {
#pragma unroll
        for (int a = 0; a < 2; ++a)
#pragma unroll
            for (int b = 0; b < 2; ++b)
#pragma unroll
                for (int m = 0; m < 4; ++m)
#pragma unroll
                    for (int n = 0; n < 2; ++n)
#pragma unroll
                        for (int q = 0; q < 4; ++q) { if (INT) acc[a][b][m][n][q] = __int_as_float(__float_as_int(acc[a][b][m][n][q]) >> 1); else acc[a][b][m][n][q] *= 0.5f; }
        e(acc, u, wr, wc, fr, fq);
    }
};
template <class Epi, class Sched, int GM>
__device__ __forceinline__ void gemm_phase(LAS unsigned char* lds, const Gemm g, const Sched& S, Epi E) {
    const int tid = tid_fresh(), wid = __builtin_amdgcn_readfirstlane(tid >> 6), lane = tid & 63, wr = wid >> 2, wc = wid & 3, fr = lane & 15, fq = lane >> 4;
    constexpr bool F8 = GM == 1;
    const int nt = g.kbytes / (BK * 2);
    const int sclA = g.sa, sclB = g.sb;
    unsigned voffA[2], voffB[2];
#pragma unroll
    for (int i = 0; i < 2; ++i) { int R, C; stage_rc(tid * 16 + i * 8192, R, C); const int Rb = Epi::PERM ? ((R & ~31) + perm32(R & 31)) : R;
        voffA[i] = (unsigned)(R * g.lda + C * 2); voffB[i] = (unsigned)(Rb * g.ldb + C * 2); }
    const size_t kstep = (size_t)(BK * 2);
    const size_t hstepA = (size_t)HALF * g.lda, hstepB = (size_t)HALF * g.ldb;
    const unsigned ldsw = (unsigned)wid * 1024u;
    const int aoff = lds_byte(wr * 64 + fr, fq * 8), boff = lds_byte(wc * 32 + fr, fq * 8);
#define PG8_SA(b, h) (((b) * 2 + (h)) * HTB)
#define PG8_SB(b, h) ((4 + (b) * 2 + (h)) * HTB)
#define PG8_STAGE(bufoff, gbase, voff) do { _Pragma("unroll") for (int _i = 0; _i < 2; ++_i) \
        __builtin_amdgcn_global_load_lds((const unsigned*)((const char*)(gbase) + (voff)[_i]), (LAS unsigned*)(lds + (bufoff) + ldsw + _i * 8192), 16, 0, 0); } while (0)
#define PG8_CAT(p) __builtin_shufflevector(*(const LAS v4i*)(p), *(const LAS v4i*)((p) + 1024), 0, 1, 2, 3, 4, 5, 6, 7)
#define PG8_LDA(dst, b, h) do { if constexpr (F8) { _Pragma("unroll") for (int m = 0; m < 4; ++m) dst##8[m] = PG8_CAT(lds + PG8_SA(b, h) + aoff + m * 2048); } \
        else { _Pragma("unroll") for (int m = 0; m < 4; ++m) _Pragma("unroll") for (int k = 0; k < 2; ++k) dst[m][k] = *(const LAS bf16x8*)(lds + PG8_SA(b, h) + aoff + m * 2048 + k * 1024); } } while (0)
#define PG8_LDB(dst, b, h) do { if constexpr (F8) { _Pragma("unroll") for (int n = 0; n < 2; ++n) dst##8[n] = PG8_CAT(lds + PG8_SB(b, h) + boff + n * 2048); } \
        else { _Pragma("unroll") for (int n = 0; n < 2; ++n) _Pragma("unroll") for (int k = 0; k < 2; ++k) dst[n][k] = *(const LAS bf16x8*)(lds + PG8_SB(b, h) + boff + n * 2048 + k * 1024); } } while (0)
#define PG8_MMA(ai, bj, At, Bt) do { __builtin_amdgcn_s_setprio(1); if constexpr (F8) { _Pragma("unroll") for (int m = 0; m < 4; ++m) _Pragma("unroll") for (int n = 0; n < 2; ++n) \
            asm volatile("v_mfma_scale_f32_16x16x128_f8f6f4 %0, %1, %2, %0, %3, %4 op_sel_hi:[0,0,0]" : "+v"(acc[ai][bj][m][n]) : "v"(Bt##8[n]), "v"(At##8[m]), "v"(sclB), "v"(sclA)); } \
        else if constexpr (GM == 2) { _Pragma("unroll") for (int m = 0; m < 4; ++m) _Pragma("unroll") for (int n = 0; n < 2; ++n) _Pragma("unroll") for (int k = 0; k < 2; ++k) \
        acc[ai][bj][m][n] = __builtin_bit_cast(f32x4, __builtin_amdgcn_mfma_i32_16x16x64_i8(__builtin_bit_cast(v4i, Bt[n][k]), __builtin_bit_cast(v4i, At[m][k]), __builtin_bit_cast(v4i, acc[ai][bj][m][n]), 0, 0, 0)); } \
        else { _Pragma("unroll") for (int m = 0; m < 4; ++m) _Pragma("unroll") for (int n = 0; n < 2; ++n) _Pragma("unroll") for (int k = 0; k < 2; ++k) \
        acc[ai][bj][m][n] = __builtin_amdgcn_mfma_f32_16x16x32_bf16(Bt[n][k], At[m][k], acc[ai][bj][m][n], 0, 0, 0); } __builtin_amdgcn_s_setprio(0); } while (0)
#define PG8_WAIT_V(n) asm volatile("s_waitcnt vmcnt(" #n ")" ::: "memory")
#define PG8_WAIT_L(n) asm volatile("s_waitcnt lgkmcnt(" #n ")" ::: "memory")
#define PG8_BAR __builtin_amdgcn_s_barrier()
#define PG8_SCHED __builtin_amdgcn_sched_barrier(0)
#define PG8_UA(u) ((const char*)g.A + (size_t)(u).pm * 2 * hstepA + (size_t)(u).kh * g.khoff)
#define PG8_UB(u) ((const char*)g.Bt + (size_t)(u).pn * 2 * hstepB + (size_t)(u).kh * g.khoff)
    Unit cur, nxt; int ui = 0;
    if (!S.next(0, cur)) return;
    Acc acc;
#pragma unroll
    for (int a = 0; a < 2; ++a)
#pragma unroll
        for (int b = 0; b < 2; ++b)
#pragma unroll
            for (int m = 0; m < 4; ++m)
#pragma unroll
                for (int n = 0; n < 2; ++n) acc[a][b][m][n] = (f32x4){0.f, 0.f, 0.f, 0.f};
    bf16x8 At[4][2], B0[2][2], B1[2][2]; v8i At8[4], B08[2], B18[2];
    const char* cA = PG8_UA(cur); const char* cB = PG8_UB(cur);
    PG8_STAGE(PG8_SB(0, 0), cB, voffB); PG8_STAGE(PG8_SB(0, 1), cB + hstepB, voffB); PG8_STAGE(PG8_SA(0, 0), cA, voffA); PG8_STAGE(PG8_SA(0, 1), cA + hstepA, voffA);
    if (wr == 1) PG8_BAR;
    PG8_WAIT_V(2); PG8_BAR;
    PG8_STAGE(PG8_SB(1, 0), cB + kstep, voffB); PG8_STAGE(PG8_SA(1, 0), cA + kstep, voffA); PG8_STAGE(PG8_SB(1, 1), cB + hstepB + kstep, voffB);
    PG8_WAIT_V(6); PG8_BAR;
    for (;;) {
        const bool has_next = S.next(ui + 1, nxt);
        const char* nA = has_next ? PG8_UA(nxt) : cA; const char* nB = has_next ? PG8_UB(nxt) : cB;
        for (int t = 0; t < nt; t += 2) {
            const bool last = (t == nt - 2);
            const char* a1 = cA + (size_t)(t + 1) * kstep;
            const char* a2 = last ? nA : cA + (size_t)(t + 2) * kstep; const char* b2 = last ? nB : cB + (size_t)(t + 2) * kstep;
            const char* a3 = a2 + kstep; const char* b3 = b2 + kstep;
            PG8_LDB(B0, 0, 0); PG8_LDB(B1, 0, 1); PG8_SCHED; PG8_LDA(At, 0, 0); PG8_STAGE(PG8_SA(1, 1), a1 + hstepA, voffA);
            PG8_WAIT_V(8); PG8_WAIT_L(0); PG8_BAR; PG8_MMA(0, 0, At, B0); PG8_MMA(0, 1, At, B1); PG8_BAR; PG8_SCHED;
            PG8_LDA(At, 0, 1); PG8_STAGE(PG8_SB(0, 0), b2, voffB); PG8_STAGE(PG8_SB(0, 1), b2 + hstepB, voffB); PG8_STAGE(PG8_SA(0, 0), a2, voffA);
            PG8_WAIT_V(8); PG8_WAIT_L(0); PG8_BAR; PG8_MMA(1, 0, At, B0); PG8_MMA(1, 1, At, B1); PG8_BAR; PG8_SCHED;
            PG8_LDB(B0, 1, 0); PG8_LDB(B1, 1, 1); PG8_SCHED; PG8_LDA(At, 1, 0); PG8_STAGE(PG8_SA(0, 1), a2 + hstepA, voffA);
            PG8_WAIT_V(8); PG8_WAIT_L(0); PG8_BAR; PG8_MMA(0, 0, At, B0); PG8_MMA(0, 1, At, B1); PG8_BAR; PG8_SCHED;
            PG8_LDA(At, 1, 1); PG8_STAGE(PG8_SB(1, 0), b3, voffB); PG8_STAGE(PG8_SB(1, 1), b3 + hstepB, voffB); PG8_STAGE(PG8_SA(1, 0), a3, voffA);
            PG8_WAIT_V(8); PG8_WAIT_L(0); PG8_BAR; PG8_MMA(1, 0, At, B0); PG8_MMA(1, 1, At, B1); PG8_BAR; PG8_SCHED;
        }
        if constexpr (F8) asm volatile("s_nop 7\n\ts_nop 7\n\ts_nop 7" ::: "memory");
        if (wr == 0) PG8_BAR;
        bool keep = false;
        if constexpr (Epi::PAIRED) { if (cur.kh == 0) { E.mid(acc, cur, wr, wc, fr, fq); keep = true; } }
        if (!keep) E(acc, cur, wr, wc, fr, fq);
        if (!has_next) break;
        if (!keep) {
#pragma unroll
            for (int a = 0; a < 2; ++a)
#pragma unroll
                for (int b = 0; b < 2; ++b)
#pragma unroll
                    for (int m = 0; m < 4; ++m)
#pragma unroll
                        for (int n = 0; n < 2; ++n) acc[a][b][m][n] = (f32x4){0.f, 0.f, 0.f, 0.f};
        }
        cur = nxt; cA = nA; cB = nB; ++ui;
        if (wr == 1) PG8_BAR;
    }
    PG8_WAIT_V(0);
    PG8_BAR;
#undef PG8_SA
#undef PG8_SB
#undef PG8_STAGE
#undef PG8_LDA
#undef PG8_CAT
#undef PG8_LDB
#undef PG8_MMA
#undef PG8_WAIT_V
#undef PG8_WAIT_L
#undef PG8_BAR
#undef PG8_SCHED
#undef PG8_UA
#undef PG8_UB
}
}

namespace att {
constexpr int D = 128, NW = 8, QBLK = 32, KVBLK = 64;
constexpr float SCALE = ATT_SCALE, THR = 8.f;
constexpr int LDQ = IN_W, LDK = IN_W, LDO = DM;
constexpr int SHM_V = KVBLK * D * 2, SHM_K = KVBLK * D * 2, SHM_ATTN = 2 * SHM_V + 2 * SHM_K + NW * 64 * 4;
#define KSWZ(row, colB) ((row) * 256 + ((colB) ^ (((row) & 7) << 4)))
#define SBAR() __builtin_amdgcn_sched_barrier(0)
__device__ __forceinline__ int crow(int r, int hi) { return (r & 3) + 8 * (r >> 2) + 4 * hi; }
__device__ __forceinline__ void partialSM(f32x16& p0, f32x16& p1, float& m_reg, float& mn, float& alpha) {
  constexpr float C = SCALE * 1.4426950408889634f;
  float pmax = p0[0];
#pragma unroll
  for (int r = 1; r < 16; ++r) pmax = fmaxf(pmax, p0[r]);
#pragma unroll
  for (int r = 0; r < 16; ++r) pmax = fmaxf(pmax, p1[r]);
  { auto rr = __builtin_amdgcn_permlane32_swap(__float_as_uint(pmax), __float_as_uint(pmax), false, false);
    pmax = fmaxf(__uint_as_float(rr[0]), __uint_as_float(rr[1])); }
  if (__builtin_expect(__all(pmax - m_reg <= THR / SCALE), 1)) { mn = m_reg; alpha = 1.f; }
  else { mn = fmaxf(m_reg, pmax); alpha = __builtin_amdgcn_exp2f((m_reg - mn) * C); m_reg = mn; }
  float mnC = -mn * C;
#pragma unroll
  for (int r = 0; r < 16; ++r) p0[r] = fmaf(p0[r], C, mnC);
#pragma unroll
  for (int r = 0; r < 16; ++r) p1[r] = fmaf(p1[r], C, mnC);
#pragma unroll
  for (int r = 0; r < 16; ++r) p0[r] = __builtin_amdgcn_exp2f(p0[r]);
}
__device__ __forceinline__ void finishSM(f32x16& p0, f32x16& p1, float alpha, float& l_reg, bf16x8& pa0, bf16x8& pa1, bf16x8& pa2, bf16x8& pa3) {
#pragma unroll
  for (int r = 0; r < 16; ++r) p1[r] = __builtin_amdgcn_exp2f(p1[r]);
  float ps = 0;
#pragma unroll
  for (int r = 0; r < 16; ++r) ps += p0[r];
#pragma unroll
  for (int r = 0; r < 16; ++r) ps += p1[r];
  { auto rr = __builtin_amdgcn_permlane32_swap(__float_as_uint(ps), __float_as_uint(ps), false, false);
    ps = __uint_as_float(rr[0]) + __uint_as_float(rr[1]); }
  l_reg = l_reg * alpha + ps;
#define PK4(P, BASE, OUT) do { unsigned a0 = cvt_pk_bf16(P[BASE + 0], P[BASE + 1]), a1 = cvt_pk_bf16(P[BASE + 2], P[BASE + 3]);   \
    unsigned b0 = cvt_pk_bf16(P[BASE + 4], P[BASE + 5]), b1 = cvt_pk_bf16(P[BASE + 6], P[BASE + 7]);                              \
    auto r0 = __builtin_amdgcn_permlane32_swap(a0, b0, false, false); auto r1 = __builtin_amdgcn_permlane32_swap(a1, b1, false, false); \
    v4u w = {r0[0], r1[0], r0[1], r1[1]}; OUT = *reinterpret_cast<bf16x8*>(&w); } while (0)
  PK4(p0, 0, pa0); PK4(p0, 8, pa1); PK4(p1, 0, pa2); PK4(p1, 8, pa3);
#undef PK4
}
__device__ __forceinline__ void qkt(f32x16& p0, f32x16& p1, const char* Ks, const bf16x8* qr, int r32, int hi) {
  p0 = f32x16{}; p1 = f32x16{};
#pragma unroll
  for (int d0 = 0; d0 < 8; ++d0) { int cb = (d0 * 16 + hi * 8) * 2;
    bf16x8 b0 = *reinterpret_cast<const bf16x8*>(Ks + KSWZ(r32, cb));
    bf16x8 b1 = *reinterpret_cast<const bf16x8*>(Ks + KSWZ(32 + r32, cb));
    p0 = __builtin_amdgcn_mfma_f32_32x32x16_bf16(b0, qr[d0], p0, 0, 0, 0);
    p1 = __builtin_amdgcn_mfma_f32_32x32x16_bf16(b1, qr[d0], p1, 0, 0, 0); }
}
__device__ __forceinline__ void win_bias(f32x16& p0, f32x16& p1, int dq, float sl) {
  const float NEG = -__builtin_inff();
#pragma unroll
  for (int r = 0; r < 16; ++r) { const int c = (r & 3) + 8 * (r >> 2);
    const int d0 = dq - c, d1 = dq - c - 32; const int a0 = d0 < 0 ? -d0 : d0, a1 = d1 < 0 ? -d1 : d1;
    p0[r] = a0 <= 128 ? fmaf(-sl, (float)a0, p0[r]) : NEG;
    p1[r] = a1 <= 128 ? fmaf(-sl, (float)a1, p1[r]) : NEG; }
}
__device__ __forceinline__ int v_st(int k, int c) { const int kk = (k & ~0xC) | ((k & 4) << 1) | ((k & 8) >> 1); return ((kk >> 3) * 4 + (c >> 5)) * 512 + ((kk & 7) * 32 + (c & 31)) * 2; }
__device__ __forceinline__ int v_rd_base(int lane) { return ((lane & 3) << 3) | (((lane >> 2) & 3) << 6) | (((lane >> 4) & 1) << 5) | (((lane >> 5) & 1) << 8); }
constexpr int v_rd_off(int d0, int ks, int half) { return d0 * 512 + ks * 4096 + half * 2048; }
template <int OFF> __device__ __forceinline__ s16x4 tr_read(int vb) {
  s16x4 r; asm volatile("ds_read_b64_tr_b16 %0, %1 offset:%2" : "=&v"(r) : "v"(vb), "i"(OFF) : "memory"); return r;
}
template <int D0> __device__ __forceinline__ void pv_one(f32x16& od, int vb, bf16x8 pa0, bf16x8 pa1, bf16x8 pa2, bf16x8 pa3) {
  const s16x4 l0 = tr_read<v_rd_off(D0, 0, 0)>(vb), h0 = tr_read<v_rd_off(D0, 0, 1)>(vb), l1 = tr_read<v_rd_off(D0, 1, 0)>(vb), h1 = tr_read<v_rd_off(D0, 1, 1)>(vb);
  const s16x4 l2 = tr_read<v_rd_off(D0, 2, 0)>(vb), h2 = tr_read<v_rd_off(D0, 2, 1)>(vb), l3 = tr_read<v_rd_off(D0, 3, 0)>(vb), h3 = tr_read<v_rd_off(D0, 3, 1)>(vb);
  asm volatile("s_waitcnt lgkmcnt(0)" ::: "memory"); SBAR();
#define PK(L, H) (bf16x8){L[0], L[1], L[2], L[3], H[0], H[1], H[2], H[3]}
  od = __builtin_amdgcn_mfma_f32_32x32x16_bf16(PK(l0, h0), pa0, od, 0, 0, 0);
  od = __builtin_amdgcn_mfma_f32_32x32x16_bf16(PK(l1, h1), pa1, od, 0, 0, 0);
  od = __builtin_amdgcn_mfma_f32_32x32x16_bf16(PK(l2, h2), pa2, od, 0, 0, 0);
  od = __builtin_amdgcn_mfma_f32_32x32x16_bf16(PK(l3, h3), pa3, od, 0, 0, 0);
#undef PK
}
__device__ __forceinline__ void pv_d0(f32x16* o, int vb, bf16x8 pa0, bf16x8 pa1, bf16x8 pa2, bf16x8 pa3) {
  pv_one<0>(o[0], vb, pa0, pa1, pa2, pa3); pv_one<1>(o[1], vb, pa0, pa1, pa2, pa3); pv_one<2>(o[2], vb, pa0, pa1, pa2, pa3); pv_one<3>(o[3], vb, pa0, pa1, pa2, pa3);
}
template <int MODE, int SDEPTH>
__device__ __forceinline__ void attn_body(const bf16* __restrict__ Qb, const bf16* __restrict__ Kh, const bf16* __restrict__ Vh, unsigned char* __restrict__ Ob, int NT, char* lds, int qrel, float sl, float sink_raw) {
  const int tid = tid_fresh(), wid = tid >> 6, lane = tid & 63, r32 = lane & 31, hi = lane >> 5;
  char* V_lds = lds; char* K_lds = lds + 2 * SHM_V;
  float m_reg = MODE ? sink_raw : -1e30f, l_reg = MODE ? 1.f : 0.f; f32x16 o[4] = {}; bf16x8 qr[8];
  const int dq0 = qrel + wid * QBLK + r32 - 4 * hi;
  const bf16* Qw = Qb + (long)(wid * QBLK + r32) * LDQ + hi * 8;
#pragma unroll
  for (int d0 = 0; d0 < 8; ++d0) qr[d0] = *reinterpret_cast<const bf16x8*>(Qw + d0 * 16);
  const int sr = tid >> 4, sc = (tid & 15) * 8, vst0 = v_st(sr, sc), vst1 = v_st(32 + sr, sc);
  const int vb0 = (int)(uintptr_t)V_lds + v_rd_base(lane);
  struct { bf16x8 vs0, vs1, ks0, ks1; } sr_[SDEPTH];
#define SLOAD(i, k0) do { sr_[i].vs0 = *reinterpret_cast<const bf16x8*>(&Vh[(long)((k0) + sr) * LDK + sc]); sr_[i].vs1 = *reinterpret_cast<const bf16x8*>(&Vh[(long)((k0) + 32 + sr) * LDK + sc]); \
    sr_[i].ks0 = *reinterpret_cast<const bf16x8*>(&Kh[(long)((k0) + sr) * LDK + sc]); sr_[i].ks1 = *reinterpret_cast<const bf16x8*>(&Kh[(long)((k0) + 32 + sr) * LDK + sc]); } while (0)
#define SWRITE(b, i) do { *(bf16x8*)(V_lds + (b) * SHM_V + vst0) = sr_[i].vs0;          \
    *(bf16x8*)(V_lds + (b) * SHM_V + vst1) = sr_[i].vs1; int kc = sc * 2;               \
    *(bf16x8*)(K_lds + (b) * SHM_K + KSWZ(sr, kc)) = sr_[i].ks0;                       \
    *(bf16x8*)(K_lds + (b) * SHM_K + KSWZ(32 + sr, kc)) = sr_[i].ks1; } while (0)
#define SWAIT() do { if constexpr (SDEPTH == 2) asm volatile("s_waitcnt vmcnt(4)" ::: "memory"); else asm volatile("s_waitcnt vmcnt(0)" ::: "memory"); } while (0)
#define RESC(a) do { if (__any((a) < 1.f)) { _Pragma("unroll") for (int d = 0; d < 4; ++d) _Pragma("unroll") for (int r = 0; r < 16; ++r) o[d][r] *= (a); } } while (0)
#define WB(P0, P1, j) do { if (MODE) win_bias(P0, P1, dq0 - (j) * KVBLK, sl); } while (0)
  f32x16 pA0, pA1, pB0, pB1; float mnA, mnB, alA, alB; bf16x8 pa0, pa1, pa2, pa3;
  constexpr int SE = 0, SO = SDEPTH - 1;
  SLOAD(SE, 0); asm volatile("s_waitcnt vmcnt(0)" ::: "memory"); SWRITE(0, SE);
  if constexpr (SDEPTH == 1) SLOAD(SO, KVBLK);
  __syncthreads();
  qkt(pA0, pA1, K_lds, qr, r32, hi); WB(pA0, pA1, 0); partialSM(pA0, pA1, m_reg, mnA, alA);
  if constexpr (SDEPTH == 2) { SLOAD(SO, KVBLK); if (2 < NT) SLOAD(SE, 2 * KVBLK); }
  SWAIT(); SWRITE(1, SO); __syncthreads();
  for (int j = 1; j + 1 < NT; j += 2) {
    SBAR(); qkt(pB0, pB1, K_lds + SHM_K, qr, r32, hi);
    finishSM(pA0, pA1, alA, l_reg, pa0, pa1, pa2, pa3); SBAR();
    SLOAD(SO, (j + SDEPTH) * KVBLK); SBAR();
    pv_d0(o, vb0, pa0, pa1, pa2, pa3); WB(pB0, pB1, j); partialSM(pB0, pB1, m_reg, mnB, alB);
    __syncthreads(); SWAIT(); SWRITE(0, SE);
    RESC(alB); __syncthreads();
    SBAR(); qkt(pA0, pA1, K_lds, qr, r32, hi);
    finishSM(pB0, pB1, alB, l_reg, pa0, pa1, pa2, pa3); SBAR();
    if (SDEPTH == 1 || j + 3 < NT) SLOAD(SE, (j + 1 + SDEPTH) * KVBLK); SBAR();
    pv_d0(o, vb0 + (int)SHM_V, pa0, pa1, pa2, pa3); WB(pA0, pA1, j + 1); partialSM(pA0, pA1, m_reg, mnA, alA);
    __syncthreads(); SWAIT(); SWRITE(1, SO);
    RESC(alA); __syncthreads();
  }
  SBAR(); qkt(pB0, pB1, K_lds + SHM_K, qr, r32, hi);
  finishSM(pA0, pA1, alA, l_reg, pa0, pa1, pa2, pa3); SBAR();
  pv_d0(o, vb0, pa0, pa1, pa2, pa3); WB(pB0, pB1, NT - 1); partialSM(pB0, pB1, m_reg, mnB, alB);
  __syncthreads(); RESC(alB);
  finishSM(pB0, pB1, alB, l_reg, pa0, pa1, pa2, pa3); SBAR();
  pv_d0(o, vb0 + (int)SHM_V, pa0, pa1, pa2, pa3);
  { const float rl = __builtin_amdgcn_rcpf(l_reg) * (float)(1 << L_Y);
    unsigned char* Ow = Ob + (long)(wid * QBLK + r32) * LDO + 4 * hi;
#pragma unroll
    for (int d0 = 0; d0 < 4; ++d0)
#pragma unroll
      for (int g = 0; g < 4; ++g) *(unsigned*)(Ow + d0 * 32 + 8 * g) = pk4_fp8(o[d0][4 * g] * rl, o[d0][4 * g + 1] * rl, o[d0][4 * g + 2] * rl, o[d0][4 * g + 3] * rl); }
#undef SLOAD
#undef SWRITE
#undef SWAIT
#undef RESC
#undef WB
}
}


namespace att8 {
typedef int v4i __attribute__((ext_vector_type(4)));
typedef int v8i __attribute__((ext_vector_type(8)));
constexpr float SCALE = ATT_SCALE, THR = 3.f;
constexpr int TB = 8192;
constexpr int SC8 = (127 - L_QK) * 0x01010101;
constexpr int SC8Q = (127 - L_QK - 3) * 0x01010101;
constexpr float THR2 = THR * 1.4426950408889634f;
#define CAT8(p) __builtin_shufflevector(*(const v4i*)(p), *(const v4i*)((p) + 16), 0, 1, 2, 3, 4, 5, 6, 7)
__device__ __forceinline__ v8i cat8x(const char* base, int off) { return __builtin_shufflevector(*(const v4i*)(base + off), *(const v4i*)(base + (off ^ 16)), 0, 1, 2, 3, 4, 5, 6, 7); }
template <bool FIRST>
__device__ __forceinline__ void softmax8(f32x16& p0, f32x16& p1, f32x16& ci, f32x16& ls, f32x16* o, v8i& P8) {
  float pmax = p0[0];
#pragma unroll
  for (int r = 1; r < 16; ++r) pmax = fmaxf(pmax, p0[r]);
#pragma unroll
  for (int r = 0; r < 16; ++r) pmax = fmaxf(pmax, p1[r]);
  { auto rr = __builtin_amdgcn_permlane32_swap(__float_as_uint(pmax), __float_as_uint(pmax), false, false);
    pmax = fmaxf(__uint_as_float(rr[0]), __uint_as_float(rr[1])); }
  if (FIRST || !__all(pmax <= THR2 + (float)L_QK)) {
    const float d = FIRST ? pmax - (float)L_QK : fmaxf(pmax - (float)L_QK, 0.f);
#pragma unroll
    for (int r = 0; r < 16; ++r) { p0[r] -= d; p1[r] -= d; ci[r] -= d; }
    if (!FIRST) { const float alpha = __builtin_amdgcn_exp2f(-d);
#pragma unroll
      for (int r = 0; r < 16; ++r) ls[r] *= alpha;
#pragma unroll
      for (int db = 0; db < 4; ++db)
#pragma unroll
        for (int r = 0; r < 16; ++r) o[db][r] *= alpha; }
  }
#pragma unroll
  for (int r = 0; r < 16; ++r) { p0[r] = __builtin_amdgcn_exp2f(p0[r]); p1[r] = __builtin_amdgcn_exp2f(p1[r]); }
#pragma unroll
  for (int k = 0; k < 4; ++k) { int w = P8[k]; w = __builtin_amdgcn_cvt_pk_fp8_f32(p0[4 * k], p0[4 * k + 1], w, false); w = __builtin_amdgcn_cvt_pk_fp8_f32(p0[4 * k + 2], p0[4 * k + 3], w, true); P8[k] = w; }
#pragma unroll
  for (int k = 0; k < 4; ++k) { int w = P8[4 + k]; w = __builtin_amdgcn_cvt_pk_fp8_f32(p1[4 * k], p1[4 * k + 1], w, false); w = __builtin_amdgcn_cvt_pk_fp8_f32(p1[4 * k + 2], p1[4 * k + 3], w, true); P8[4 + k] = w; }
}
__device__ __forceinline__ void qkt8(f32x16& p0, f32x16& p1, const char* Kt, const v8i (&q8)[2], int ka0, int ka1, const f32x16& ci, const v8i& k00, const v8i& k10) {
  p0 = __builtin_amdgcn_mfma_scale_f32_32x32x64_f8f6f4(k00, q8[0], ci, 0, 0, 0, SC8, 0, SC8Q);
  p1 = __builtin_amdgcn_mfma_scale_f32_32x32x64_f8f6f4(k10, q8[0], ci, 0, 0, 0, SC8, 0, SC8Q);
  p0 = __builtin_amdgcn_mfma_scale_f32_32x32x64_f8f6f4(cat8x(Kt, ka1), q8[1], p0, 0, 0, 0, SC8, 0, SC8Q);
  p1 = __builtin_amdgcn_mfma_scale_f32_32x32x64_f8f6f4(cat8x(Kt + 4096, ka1), q8[1], p1, 0, 0, 0, SC8, 0, SC8Q);
}
__device__ __forceinline__ void pv8(f32x16* o, const char* Vt, const v8i& P8, int va, f32x16& ls, const v8i& ones) {
#pragma unroll
  for (int db = 0; db < 4; ++db) o[db] = __builtin_amdgcn_mfma_scale_f32_32x32x64_f8f6f4(cat8x(Vt + db * 2048, va), P8, o[db], 0, 0, 0, SC8, 0, SC8);
  ls = __builtin_amdgcn_mfma_scale_f32_32x32x64_f8f6f4(ones, P8, ls, 0, 0, 0, 127 * 0x01010101, 0, 127 * 0x01010101);
}
template <int MODE>
__device__ __forceinline__ void attn_a8(const unsigned char* __restrict__ Q8, const unsigned char* __restrict__ K8, const unsigned char* __restrict__ VT, unsigned char* __restrict__ Ob, int NT, char* lds, int qrel, float sl, float sink_raw) {
  const int tid = tid_fresh(), wid = tid >> 6, lane = tid & 63, r32 = lane & 31, hi = lane >> 5;
  char* K_lds = lds; char* V_lds = lds + 4 * TB;
  const float m_reg = MODE ? sink_raw : 0.f; f32x16 o[4] = {}; v8i q8[2];
  f32x16 ls; v8i ones;
  { float l0 = MODE ? (float)(1 << L_QK) : 0.f; int one4 = 0x38383838; asm volatile("" : "+v"(l0), "+v"(one4));
#pragma unroll
    for (int r = 0; r < 16; ++r) ls[r] = l0;
#pragma unroll
    for (int r = 0; r < 8; ++r) ones[r] = one4; }
  f32x16 ci;
  { float c0 = (float)L_QK - m_reg; asm volatile("" : "+v"(c0));
#pragma unroll
    for (int r = 0; r < 16; ++r) ci[r] = c0; }
  const int dq0 = qrel + wid * 32 + r32 - 4 * hi;
#define WB8(P0, P1, j) do { if (MODE) att::win_bias(P0, P1, dq0 - (j) * 64, sl); } while (0)
  { const unsigned char* qp = Q8 + (long)(wid * 32 + r32) * 2048 + 32 * hi; q8[0] = CAT8(qp); q8[1] = CAT8(qp + 64); }
  const int swk = (r32 >> 1) & 7, swv = (r32 >> 2) & 3;
  const int ka0 = r32 * 128 + (((0 + 2 * hi) ^ swk) << 4), ka1 = r32 * 128 + (((4 + 2 * hi) ^ swk) << 4);
  const int va = r32 * 64 + (((2 * hi) ^ swv) << 4);
  const int kr = tid >> 3, vd = tid >> 2; const bool late = wid >= 4;
  const unsigned goK = (unsigned)(kr * 512 + (((tid & 7) ^ ((kr >> 1) & 7)) << 4)), goV = (unsigned)(vd * 64 + (((tid & 3) ^ ((vd >> 2) & 3)) << 4));
  LAS char* const Lw = (LAS char*)lds + __builtin_amdgcn_readfirstlane(wid) * 1024;
#define DMAK8(j, rb) __builtin_amdgcn_global_load_lds((const unsigned*)((const char*)K8 + (size_t)(j) * (64 * 512) + goK), (LAS unsigned*)(Lw + (rb)), 16, 0, 0)
#define DMAV8(j, rb) __builtin_amdgcn_global_load_lds((const unsigned*)((const char*)VT + (size_t)(j) * (4 * TB) + goV), (LAS unsigned*)(Lw + 4 * TB + (rb)), 16, 0, 0)
#define WAITV8(n) asm volatile("s_waitcnt vmcnt(" #n ") lgkmcnt(0)" ::: "memory")
#define BAR8() do { __builtin_amdgcn_s_barrier(); asm volatile("" ::: "memory"); } while (0)
  f32x16 p0, p1; v8i P8 = {}, kf0, kf1;
#define KPRE8(KR) do { kf0 = cat8x(K_lds + (KR), ka0); kf1 = cat8x(K_lds + (KR) + 4096, ka0); } while (0)
  __syncthreads();
  DMAK8(0, 0); DMAV8(0, 0); DMAK8(1, TB); DMAK8(2, 2 * TB); WAITV8(3); BAR8();
  if (late) { WAITV8(0); BAR8(); }
  __builtin_amdgcn_s_setprio(1);
  KPRE8(0);
  qkt8(p0, p1, K_lds, q8, ka0, ka1, ci, kf0, kf1); __builtin_amdgcn_sched_barrier(0);
  DMAK8(3 < NT ? 3 : NT - 1, 3 < NT ? 3 * TB : 8 * TB); DMAV8(1, TB);
  WAITV8(2);
  __builtin_amdgcn_s_setprio(0); BAR8();
  WB8(p0, p1, 0); softmax8<MODE == 0>(p0, p1, ci, ls, o, P8); KPRE8(TB); BAR8();
#define STEP8(t, KR, VR, KN) do { const int t_ = (t); const bool sk = t_ + 3 < NT, sv = t_ + 1 < NT; \
    __builtin_amdgcn_s_setprio(1); \
    qkt8(p0, p1, K_lds + (KR), q8, ka0, ka1, ci, kf0, kf1); __builtin_amdgcn_sched_barrier(0); \
    DMAK8(sk ? t_ + 3 : NT - 1, sk ? (VR) : 8 * TB); DMAV8(sv ? t_ + 1 : NT - 1, sv ? (KN) : 5 * TB);     \
    __builtin_amdgcn_sched_barrier(0); pv8(o, V_lds + (VR), P8, va, ls, ones); \
    WAITV8(2); \
    __builtin_amdgcn_s_setprio(0); BAR8(); \
    WB8(p0, p1, t_); softmax8<false>(p0, p1, ci, ls, o, P8); KPRE8(KN); BAR8(); } while (0)
  int t = 1;
  for (; t + 3 < NT; t += 4) { STEP8(t, TB, 0, 2 * TB); STEP8(t + 1, 2 * TB, TB, 3 * TB); STEP8(t + 2, 3 * TB, 2 * TB, 0); STEP8(t + 3, 0, 3 * TB, TB); }
  const int rem = NT - t;
  if (rem >= 1) STEP8(t, TB, 0, 2 * TB);
  if (rem >= 2) STEP8(t + 1, 2 * TB, TB, 3 * TB);
  if (rem >= 3) STEP8(t + 2, 3 * TB, 2 * TB, 0);
  if (rem == 0) pv8(o, V_lds, P8, va, ls, ones); else if (rem == 1) pv8(o, V_lds + TB, P8, va, ls, ones); else if (rem == 2) pv8(o, V_lds + 2 * TB, P8, va, ls, ones); else pv8(o, V_lds + 3 * TB, P8, va, ls, ones);
  WAITV8(0); BAR8();
  if (!late) BAR8();
#undef STEP8
#undef KPRE8
#undef DMAK8
#undef DMAV8
#undef WAITV8
#undef BAR8
  { const float rl = __builtin_amdgcn_rcpf(ls[0]) * (float)(1 << (L_Y + L_QK));
    const int t2 = tid_fresh(), w2 = t2 >> 6, l2 = t2 & 63; LAS char* st = (LAS char*)lds + w2 * 4096;
    { LAS char* sw = st + (l2 & 31) * 128 + 4 * (l2 >> 5);
#pragma unroll
      for (int d0 = 0; d0 < 4; ++d0)
#pragma unroll
        for (int g = 0; g < 4; ++g) *(LAS unsigned*)(sw + d0 * 32 + 8 * g) = pk4_fp8(o[d0][4 * g] * rl, o[d0][4 * g + 1] * rl, o[d0][4 * g + 2] * rl, o[d0][4 * g + 3] * rl); }
#pragma unroll
    for (int k = 0; k < 4; ++k) { const int row = 8 * k + (l2 >> 3), ch = l2 & 7;
      const v4i wv = *(const LAS v4i*)(st + row * 128 + ch * 16);
      *(v4i*)(Ob + (size_t)(w2 * 32 + row) * DM + ch * 16) = wv; }
    asm volatile("s_waitcnt lgkmcnt(0)" ::: "memory"); }
#undef WB8
}
#undef CAT8
}

#define XB_TMO      128
#define XB_XCNT(j)  (256  + 64 * (j))
#define XB_XSUB(j)  (1280 + 64 * (j))
#define XB_XGEN(j)  (2304 + 64 * (j))
#define XB_TOP      3328
#define XB_TOPGEN   3392
#define XCD_BAR_WORDS 3456
#define XB_SPIN_CAP (1u << 18)
__device__ __forceinline__ unsigned xb_ld(unsigned* p)              { return __hip_atomic_load(p, __ATOMIC_RELAXED, __HIP_MEMORY_SCOPE_AGENT); }
__device__ __forceinline__ unsigned xb_add(unsigned* p, unsigned v) { return __hip_atomic_fetch_add(p, v, __ATOMIC_RELAXED, __HIP_MEMORY_SCOPE_AGENT); }
__device__ __forceinline__ unsigned xb_xcc_id() { return (unsigned)__builtin_amdgcn_s_getreg((3 << 11) | 20) & 0xFu; }
#define XB_SPIN(cond, bar) do { unsigned _sp = 0; while (cond) { __builtin_amdgcn_s_sleep(1); \
    if ((++_sp & 255u) == 0u) { if (xb_ld(&(bar)[XB_TMO])) break; if (_sp > XB_SPIN_CAP) { atomicAdd(&(bar)[XB_TMO], 1u); break; } } } } while (0)
struct XcdBarrier { unsigned* bar; unsigned x; volatile LAS unsigned* st; };
__device__ __forceinline__ XcdBarrier xcd_barrier_post(unsigned* bar, volatile LAS unsigned* st) {
    XcdBarrier b; b.bar = bar; b.x = xb_xcc_id(); b.st = st;
    if (threadIdx.x == 0) (void)xb_add(&bar[XB_XCNT(b.x)], 1u);
    return b;
}
__device__ __forceinline__ void xcd_barrier_complete(unsigned* bar, unsigned x, unsigned& nloc, unsigned& nx) {
    const unsigned G = gridDim.x * gridDim.y * gridDim.z;
    unsigned sum, cnt, mine, sp = 0u;
    for (;;) {
        sum = 0u; cnt = 0u; mine = 0u;
#pragma unroll
        for (unsigned j = 0; j < 16; ++j) { const unsigned c = xb_ld(&bar[XB_XCNT(j)]); sum += c; cnt += (c > 0u) ? 1u : 0u; mine = (j == x) ? c : mine; }
        if (sum == G) break;
        __builtin_amdgcn_s_sleep(1);
        if ((++sp & 255u) == 0u) { if (xb_ld(&bar[XB_TMO])) break; if (sp > XB_SPIN_CAP) { atomicAdd(&bar[XB_TMO], 1u); break; } }
    }
    nloc = mine > 0u ? mine : 1u; nx = cnt > 0u ? cnt : 1u;
}
__device__ __forceinline__ void xcd_barrier(const XcdBarrier& b) {
    asm volatile("s_waitcnt vmcnt(0)" ::: "memory");
    __syncthreads();
    if (threadIdx.x == 0) {
        unsigned* bar = b.bar;
        __builtin_amdgcn_s_waitcnt(0);
        unsigned nloc = b.st[0], nx = b.st[1];
        if (nloc == 0u) { xcd_barrier_complete(bar, b.x, nloc, nx); b.st[0] = nloc; b.st[1] = nx; }
        const unsigned old = xb_add(&bar[XB_XSUB(b.x)], 1u);
        const unsigned gen = old / nloc;
        if (old + 1u == (gen + 1u) * nloc) {
            __builtin_amdgcn_fence(__ATOMIC_RELEASE, "agent");
            asm volatile("s_waitcnt vmcnt(0)" ::: "memory");
            const unsigned og = xb_add(&bar[XB_TOP], 1u);
            const unsigned tg = og / nx;
            if (og + 1u == (tg + 1u) * nx) xb_add(&bar[XB_TOPGEN], 1u);
            else XB_SPIN(xb_ld(&bar[XB_TOPGEN]) == tg, bar);
            __builtin_amdgcn_fence(__ATOMIC_ACQUIRE, "agent");
            xb_add(&bar[XB_XGEN(b.x)], 1u);
            asm volatile("s_waitcnt vmcnt(0)" ::: "memory");
        } else {
            XB_SPIN(xb_ld(&bar[XB_XGEN(b.x)]) == gen, bar);
            __builtin_amdgcn_fence(__ATOMIC_ACQUIRE, "agent");
            asm volatile("s_waitcnt vmcnt(0)" ::: "memory");
        }
    }
    __syncthreads();
}

struct Args { const float* in[20]; float* out; unsigned char* ws; int ph_lo, ph_hi; };
struct Frame {
    LAS unsigned char* lds;
    int tid, lane, wave, vcu, G;
    const float *xp, *xs, *cp, *cs, *w_ada, *b_ada, *w_in, *qn, *kn, *sink, *wbra, *wbrb, *wo, *ln1g, *ln1b, *wg, *wu, *wd, *ln2g, *ln2b;
    float* out; float* mod; float* rope; float* rsc; float* csc; unsigned* cmax;
    bf16 *Win_t, *Wbr_t, *Wo_t, *Wgu_t, *Wd_t, *H, *Y, *P;
    unsigned char *QA8, *KA8, *VT8, *QB8, *KB8, *VTB8;
};
typedef const __attribute__((address_space(4))) Args* KArgs;
__device__ __forceinline__ void frame_ptrs(Frame& F) {
    unsigned long long kp = (unsigned long long)__builtin_amdgcn_kernarg_segment_ptr(); asm volatile("" : "+s"(kp));
    KArgs a = (KArgs)kp; unsigned char* ws = a->ws;
    F.tid = tid_fresh(); F.lane = F.tid & 63; F.wave = __builtin_amdgcn_readfirstlane(F.tid >> 6);
    F.xp = a->in[0]; F.xs = a->in[1]; F.cp = a->in[2]; F.cs = a->in[3]; F.w_ada = a->in[4]; F.b_ada = a->in[5]; F.w_in = a->in[6]; F.qn = a->in[7]; F.kn = a->in[8]; F.sink = a->in[9];
    F.wbra = a->in[10]; F.wbrb = a->in[11]; F.wo = a->in[12]; F.ln1g = a->in[13]; F.ln1b = a->in[14]; F.wg = a->in[15]; F.wu = a->in[16]; F.wd = a->in[17]; F.ln2g = a->in[18]; F.ln2b = a->in[19];
    F.out = a->out; F.mod = (float*)(ws + WS_MOD); F.rope = (float*)(ws + WS_ROPE); F.rsc = (float*)(ws + WS_RSC); F.csc = (float*)(ws + WS_CSC); F.cmax = (unsigned*)(ws + WS_CTL) + CW_CMAX;
    F.Win_t = (bf16*)(ws + WS_WIN); F.Wbr_t = (bf16*)(ws + WS_WBR); F.Wo_t = (bf16*)(ws + WS_WO); F.Wgu_t = (bf16*)(ws + WS_WGU); F.Wd_t = (bf16*)(ws + WS_WD);
    F.H = (bf16*)(ws + WS_H); F.Y = (bf16*)(ws + WS_Y); F.P = (bf16*)(ws + WS_P);
    F.QA8 = ws + WS_QA8; F.KA8 = ws + WS_KA8; F.VT8 = ws + WS_VT8; F.QB8 = ws + WS_QB8; F.KB8 = ws + WS_KB8; F.VTB8 = ws + WS_VTB8;
}
__device__ __forceinline__ float wave_sum(float v) {
#pragma unroll
    for (int o = 1; o < 64; o <<= 1) v += __shfl_xor(v, o);
    return v;
}
__device__ __forceinline__ void p0_transpose_tile(const float* W, int N, int k0, int n0, bf16* WT, int dst_row0, int dst_k0, int ldk, LAS float* scr, int lane) {
    { f32x4 t_[8]; const int c4 = 4 * (lane & 7);
#pragma unroll
      for (int i = 0; i < 8; ++i) t_[i] = __builtin_nontemporal_load((const f32x4*)(W + (size_t)(k0 + 8 * i + (lane >> 3)) * N + n0 + c4));
#pragma unroll
      for (int i = 0; i < 8; ++i) { LAS float* d_ = scr + (8 * i + (lane >> 3)) * 33 + c4; d_[0] = t_[i][0]; d_[1] = t_[i][1]; d_[2] = t_[i][2]; d_[3] = t_[i][3]; } }
    LDS_WAIT(); asm volatile("" ::: "memory");
    const int c = lane & 7;
#pragma unroll
    for (int j = 0; j < 4; ++j) { const int n = (lane >> 3) + 8 * j; const LAS float* s = scr + (8 * c) * 33 + n;
        v4u o; o.x = cvt_pk_bf16(s[0 * 33], s[1 * 33]); o.y = cvt_pk_bf16(s[2 * 33], s[3 * 33]); o.z = cvt_pk_bf16(s[4 * 33], s[5 * 33]); o.w = cvt_pk_bf16(s[6 * 33], s[7 * 33]);
        *(GAS v4u*)(WT + (size_t)(dst_row0 + n) * ldk + dst_k0 + 8 * c) = o; }
    LDS_WAIT(); asm volatile("" ::: "memory");
}
template <bool QKP>
__device__ __forceinline__ void p0_transpose_tile_f8(const float* W, int N, int k0, int n0, unsigned char* WT, int dst_row0, int dst_k0, int ldk, float sc, LAS float* scr, int lane) {
    { f32x4 t_[8]; const int c4 = 4 * (lane & 7);
#pragma unroll
      for (int i = 0; i < 8; ++i) t_[i] = __builtin_nontemporal_load((const f32x4*)(W + (size_t)(k0 + 8 * i + (lane >> 3)) * N + n0 + c4));
#pragma unroll
      for (int i = 0; i < 8; ++i) { LAS float* d_ = scr + (8 * i + (lane >> 3)) * 33 + c4; d_[0] = t_[i][0]; d_[1] = t_[i][1]; d_[2] = t_[i][2]; d_[3] = t_[i][3]; } }
    LDS_WAIT(); asm volatile("" ::: "memory");
    const int c = lane & 7;
#pragma unroll
    for (int j = 0; j < 4; ++j) { const int n = (lane >> 3) + 8 * j; const LAS float* s = scr + (8 * c) * 33 + n;
        v2u o; o.x = pk4_fp8(s[0 * 33] * sc, s[1 * 33] * sc, s[2 * 33] * sc, s[3 * 33] * sc); o.y = pk4_fp8(s[4 * 33] * sc, s[5 * 33] * sc, s[6 * 33] * sc, s[7 * 33] * sc);
        const int t_ = (n0 >> 5) & 3; const int row = QKP ? (n0 & ~127) + 64 * (t_ >> 1) + 32 * (n >> 4) + 8 * ((n >> 2) & 3) + 4 * (t_ & 1) + (n & 3) : dst_row0 + n;
        *(GAS v2u*)(WT + (size_t)row * ldk + dst_k0 + 8 * c) = o; }
    LDS_WAIT(); asm volatile("" ::: "memory");
}
__device__ __forceinline__ void p0_transpose_tile_i8(const float* W, int N, int k0, int n0, unsigned char* WT, int dst_row0, int dst_k0, int ldk, const unsigned* cm, LAS float* scr, int lane) {
    { f32x4 t_[8]; const int c4 = 4 * (lane & 7);
#pragma unroll
      for (int i = 0; i < 8; ++i) t_[i] = __builtin_nontemporal_load((const f32x4*)(W + (size_t)(k0 + 8 * i + (lane >> 3)) * N + n0 + c4));
#pragma unroll
      for (int i = 0; i < 8; ++i) { LAS float* d_ = scr + (8 * i + (lane >> 3)) * 33 + c4; d_[0] = t_[i][0]; d_[1] = t_[i][1]; d_[2] = t_[i][2]; d_[3] = t_[i][3]; } }
    LDS_WAIT(); asm volatile("" ::: "memory");
    const int c = lane & 7;
#pragma unroll
    for (int j = 0; j < 4; ++j) { const int n = (lane >> 3) + 8 * j; const LAS float* s = scr + (8 * c) * 33 + n;
        const float mx = __uint_as_float(cm[dst_row0 + n]); const float inv = mx > 0.f ? 127.0f / mx : 0.f; int q[8];
#pragma unroll
        for (int e = 0; e < 8; ++e) q[e] = (int)__builtin_rintf(s[e * 33] * inv) & 0xff;
        v2u o; o.x = (unsigned)(q[0] | (q[1] << 8) | (q[2] << 16) | (q[3] << 24)); o.y = (unsigned)(q[4] | (q[5] << 8) | (q[6] << 16) | (q[7] << 24));
        *(GAS v2u*)(WT + (size_t)(dst_row0 + n) * ldk + dst_k0 + 8 * c) = o; }
    LDS_WAIT(); asm volatile("" ::: "memory");
}
__device__ __forceinline__ void sincos_poly(double y, double& s, double& c) {
    const double y2 = y * y; double ts = y, tc = 1.0; s = y; c = 1.0;
#pragma unroll
    for (int n = 1; n <= 15; ++n) { tc *= -y2 * (1.0 / (double)((2 * n - 1) * (2 * n))); c += tc; ts *= -y2 * (1.0 / (double)((2 * n) * (2 * n + 1))); s += ts; }
}

__device__ __forceinline__ void phase0(Frame& F) {
    LAS float* sc = (LAS float*)F.lds;
    LAS float* part = (LAS float*)(F.lds + 81920);
    for (int i = F.tid; i < NBATCH * DM; i += NWAVES * 64) { const float c = i < DM ? F.cp[i] : F.cs[i - DM]; sc[i] = c * sigmoidf_(c); }
    __syncthreads();
    for (int cb = F.vcu; cb < (NMOD * DM) / 96; cb += F.G) {
        if (F.tid < 504) { const int ct = F.tid % 24, kg = F.tid / 24; const float* wp = F.w_ada + (size_t)cb * 96 + 4 * ct;
            f32x4 a0 = {0, 0, 0, 0}, a1 = a0, a2 = a0, a3 = a0, a4 = a0;
#pragma unroll 4
            for (int k = kg; k < DM; k += 21) { const f32x4 wv = *(const f32x4*)(wp + (size_t)k * (NMOD * DM));
                a0 += wv * sc[k]; a1 += wv * sc[DM + k]; a2 += wv * sc[2 * DM + k]; a3 += wv * sc[3 * DM + k]; a4 += wv * sc[4 * DM + k]; }
            LAS f32x4* pp = (LAS f32x4*)(part + (kg * 24 + ct) * 20); pp[0] = a0; pp[1] = a1; pp[2] = a2; pp[3] = a3; pp[4] = a4; }
        __syncthreads();
        if (F.tid < 480) { const int b = F.tid / 96, j = F.tid % 96, ct = j >> 2, e = j & 3; float s = F.b_ada[cb * 96 + j];
            for (int kg = 0; kg < 21; ++kg) s += part[(kg * 24 + ct) * 20 + b * 4 + e];
            F.mod[(size_t)b * NMOD * DM + cb * 96 + j] = s; }
        __syncthreads();
    }
    { const int gt = F.vcu * NWAVES * 64 + F.tid;
      if (gt < 6144) { const int isc = gt >= 4096, idx = isc ? gt - 4096 : gt, pos = idx >> 5, i = idx & 31;
          double inv = 1.0; for (int k = 0; k < i; ++k) inv *= 0.7498942093324559;
          const double ang = (double)pos * inv; const double kq = __builtin_rint(ang * 0.15915494309189535); const double y = ang - kq * 6.283185307179586;
          double s, c; sincos_poly(y, s, c);
          float* cosp = F.rope + (isc ? 8192 : 0); float* sinp = cosp + (isc ? 2048 : 4096);
          cosp[idx] = (float)c; sinp[idx] = (float)s; } }
    LAS float* scr = (LAS float*)(F.lds + F.wave * 16384);
    const int gw = F.vcu * NWAVES + F.wave, NGW = F.G * NWAVES;
    constexpr int I_IN = (DM / 64) * (IN_W / 32);
    for (int it = gw; it < I_IN; it += NGW) { const int nb = IN_W / 32, kb = it / nb, n0 = 32 * (it % nb);
        if (n0 < C_VA) p0_transpose_tile_f8<true>(F.w_in, IN_W, 64 * kb, n0, (unsigned char*)F.Win_t, n0, 64 * kb, DM, (float)(1 << L_WIN), scr, F.lane);
        else p0_transpose_tile_f8<false>(F.w_in, IN_W, 64 * kb, n0, (unsigned char*)F.Win_t, n0, 64 * kb, DM, (float)(1 << L_WIN), scr, F.lane); }
}
__device__ __forceinline__ void side2(Frame& F) {
    LAS float* scr = (LAS float*)(F.lds + F.wave * 16384);
    const int gw = F.vcu * NWAVES + F.wave, NGW = F.G * NWAVES;
    constexpr int I_BR = (2048 / 64) * (DM / 32), I_O = (DM / 64) * (DM / 32), I_D = (DFF / 64) * (DM / 32);
    constexpr int NITEMS = 2 * I_BR + I_O + I_D;
    for (int it = gw; it < NITEMS; it += NGW) {
        int r = it;
        if (r < I_BR) { const int nb = DM / 32, kb = r / nb, n0 = 32 * (r % nb); p0_transpose_tile_f8<false>(F.wbra, DM, 64 * kb, n0, (unsigned char*)F.Wbr_t, n0, 64 * kb, DM, (float)(1 << L_WBR), scr, F.lane); continue; } r -= I_BR;
        if (r < I_BR) { const int nb = DM / 32, kb = r / nb, n0 = 32 * (r % nb); p0_transpose_tile_f8<false>(F.wbrb, DM, 64 * kb, n0, (unsigned char*)F.Wbr_t, n0, 2048 + 64 * kb, DM, (float)(1 << L_WBR), scr, F.lane); continue; } r -= I_BR;
        if (r < I_O) { const int nb = DM / 32, kb = r / nb, n0 = 32 * (r % nb); p0_transpose_tile_f8<false>(F.wo, DM, 64 * kb, n0, (unsigned char*)F.Wo_t, n0, 64 * kb, DM, (float)(1 << L_WO), scr, F.lane); continue; } r -= I_O;
        { const int nb = DM / 32, kb = r / nb, n0 = 32 * (r % nb); p0_transpose_tile(F.wd, DM, 64 * kb, n0, F.Wd_t, n0, 64 * kb, DFF, scr, F.lane); }
    }
    for (int it = gw; it < 2 * 16 * 43; it += NGW) { const int mat = it / (16 * 43), r = it % (16 * 43), ks = r / 43, cb = r % 43; const int c = cb * 256 + 4 * F.lane;
        const float* wp = (mat ? F.wu : F.wg) + (size_t)(ks * 256) * DFF + c; f32x4 mx = {0.f, 0.f, 0.f, 0.f};
#pragma unroll 8
        for (int k = 0; k < 256; ++k) { const f32x4 wv = __builtin_nontemporal_load((const f32x4*)(wp + (size_t)k * DFF)); mx = __builtin_elementwise_max(mx, __builtin_elementwise_abs(wv)); }
        unsigned* cm = F.cmax + 256 * (c >> 7) + (mat ? 128 : 0) + (c & 127);
#pragma unroll
        for (int e = 0; e < 4; ++e) atomicMax(cm + e, __float_as_uint(mx[e])); }
}
__device__ __forceinline__ void side4(Frame& F) {
    LAS float* scr = (LAS float*)(F.lds + F.wave * 16384);
    const int gw = F.vcu * NWAVES + F.wave, NGW = F.G * NWAVES;
    constexpr int I_G = (DM / 64) * (DFF / 32);
    for (int it = gw; it < 2 * I_G; it += NGW) { const int mat = it >= I_G, r = mat ? it - I_G : it; const int nb = DFF / 32, kb = r / nb, n0 = 32 * (r % nb);
        p0_transpose_tile_i8(mat ? F.wu : F.wg, DFF, 64 * kb, n0, (unsigned char*)F.Wgu_t, 256 * (n0 >> 7) + (mat ? 128 : 0) + (n0 & 127), 64 * kb, DM, F.cmax, scr, F.lane); }
    for (int i = F.vcu * NWAVES * 64 + F.tid; i < 2 * DFF; i += F.G * NWAVES * 64) F.csc[i] = __uint_as_float(F.cmax[i]) * (1.0f / 127.0f);
}
__device__ __forceinline__ void row_stats(const f32x4 (&v)[16], float& mean, float& rstd) {
    float s = 0.f;
#pragma unroll
    for (int j = 0; j < 16; ++j) s += (v[j].x + v[j].y) + (v[j].z + v[j].w);
    mean = wave_sum(s) * (1.f / DM); float s2 = 0.f;
#pragma unroll
    for (int j = 0; j < 16; ++j) { const f32x4 d = v[j] - mean; s2 += (d.x * d.x + d.y * d.y) + (d.z * d.z + d.w * d.w); }
    rstd = 1.f / sqrtf(wave_sum(s2) * (1.f / DM) + LN_EPS);
}
__device__ __forceinline__ int row_batch(int m) { return m < SEQ_P ? 0 : 1 + ((m - SEQ_P) >> 12); }
__device__ __forceinline__ f32x4 ldg4(const float* base, unsigned off) { return *(const GAS f32x4*)((const GAS char*)base + off); }
__device__ __forceinline__ void stg4(float* base, unsigned off, f32x4 v) { *(GAS f32x4*)((GAS char*)base + off) = v; }
__device__ __forceinline__ void stg1(void* base, unsigned off, unsigned v) { *(GAS unsigned*)((GAS char*)base + off) = v; }
__device__ __forceinline__ void phase1(Frame& F) {
    const int gw = F.vcu * NWAVES + F.wave, NGW = F.G * NWAVES; const unsigned lo = (unsigned)F.lane * 16u;
    for (int m = gw; m < M; m += NGW) {
        const float* xrow = m < SEQ_P ? F.xp + (size_t)m * DM : F.xs + (size_t)(m - SEQ_P) * DM;
        const float* md = F.mod + (size_t)row_batch(m) * NMOD * DM;
        f32x4 v[16];
#pragma unroll
        for (int j = 0; j < 16; ++j) v[j] = ldg4(xrow, lo + 1024u * j);
        float mean, rstd; row_stats(v, mean, rstd);
        unsigned char* orow = (unsigned char*)F.H + (size_t)m * DM; constexpr float SC = (float)(1 << L_H1);
#pragma unroll
        for (int j = 0; j < 16; ++j) { const f32x4 sh = ldg4(md, lo + 1024u * j), scl = ldg4(md + DM, lo + 1024u * j);
            const f32x4 y = ((v[j] - mean) * rstd * (scl + 1.0f) + sh) * SC; stg1(orow, (unsigned)F.lane * 4u + 256u * j, pk4_fp8(y.x, y.y, y.z, y.w)); }
    }
}
__device__ __forceinline__ void phase4(Frame& F, char* lds) {
    for (int idx = F.vcu; idx < 1536; idx += F.G) {
        const bool pr = idx < 512; const int u = pr ? idx : idx - 512;
        const int head = pr ? u >> 5 : (u >> 4) & 15, qb = pr ? u & 31 : u & 15; const size_t row0 = pr ? 0 : SEQ_P + (size_t)(u >> 8) * SEQ_S;
        att8::attn_a8<0>(F.QA8 + (row0 + qb * 256) * 2048 + head * HD, F.KA8 + row0 * 512 + (head >> 2) * HD, F.VT8 + ((row0 >> 6) * 4 + (head >> 2)) * (size_t)att8::TB,
            (unsigned char*)F.Y + (row0 + qb * 256) * DM + head * HD, pr ? SEQ_P / 64 : SEQ_S / 64, lds, 0, 0.f, 0.f); }
    for (int u = F.vcu; u < 1536; u += F.G) { const int pm = u >> 4, head = u & 15;
        const int T = pm < 32 ? SEQ_P : SEQ_S, qb = pm < 32 ? pm : (pm - 32) & 15; const size_t row0 = pm < 32 ? 0 : SEQ_P + (size_t)((pm - 32) >> 4) * SEQ_S;
        const int q0 = qb * 256, ks = q0 >= 128 ? q0 - 128 : 0, ke = q0 + 384 <= T ? q0 + 384 : T;
        const float slope = __builtin_amdgcn_exp2f(-0.5f * (float)(head + 1));
        const size_t kr0 = row0 + ks; att8::attn_a8<1>(F.QB8 + (row0 + q0) * 2048 + head * HD, F.KB8 + kr0 * 512 + (head >> 2) * HD, F.VTB8 + ((kr0 >> 6) * 4 + (head >> 2)) * (size_t)att8::TB,
            (unsigned char*)F.Y + (row0 + q0) * DM + 2048 + head * HD, (ke - ks) / 64, lds, q0 - ks, slope * 1.4426950408889634f, F.sink[head] * 1.4426950408889634f); }
}
__device__ __forceinline__ void ld_row_h(const unsigned short* row, unsigned lane, f32x4 (&v)[16]) {
#pragma unroll
    for (int j = 0; j < 8; ++j) { const v4u hv = *(const GAS v4u*)((const GAS char*)row + lane * 16u + 1024u * j);
        v[2 * j] = (f32x4){h_lo(hv.x), h_hi(hv.x), h_lo(hv.y), h_hi(hv.y)}; v[2 * j + 1] = (f32x4){h_lo(hv.z), h_hi(hv.z), h_lo(hv.w), h_hi(hv.w)}; }
}
__device__ __forceinline__ void phase7(Frame& F) {
    const int gw = F.vcu * NWAVES + F.wave, NGW = F.G * NWAVES; const unsigned ln = (unsigned)F.lane, lo = ln * 32u;
    for (int m = gw; m < M; m += NGW) {
        const float* md = F.mod + (size_t)row_batch(m) * NMOD * DM;
        f32x4 v[16]; ld_row_h((const unsigned short*)F.P + (size_t)m * DM, ln, v);
        float mean, rstd; row_stats(v, mean, rstd);
        unsigned short* xrow = (unsigned short*)F.H + (size_t)m * DM;
#pragma unroll
        for (int j = 0; j < 8; ++j) {
#pragma unroll
            for (int h = 0; h < 2; ++h) { const f32x4 g = ldg4(F.ln1g, lo + 2048u * j + 16u * h), b = ldg4(F.ln1b, lo + 2048u * j + 16u * h); v[2 * j + h] = (v[2 * j + h] - mean) * rstd * g + b; }
            v4u w; w.x = pk_h2(v[2 * j].x, v[2 * j].y); w.y = pk_h2(v[2 * j].z, v[2 * j].w); w.z = pk_h2(v[2 * j + 1].x, v[2 * j + 1].y); w.w = pk_h2(v[2 * j + 1].z, v[2 * j + 1].w);
            *(GAS v4u*)((GAS char*)xrow + ln * 16u + 1024u * j) = w;
            v[2 * j] = (f32x4){h_lo(w.x), h_hi(w.x), h_lo(w.y), h_hi(w.y)}; v[2 * j + 1] = (f32x4){h_lo(w.z), h_hi(w.z), h_lo(w.w), h_hi(w.w)}; }
        row_stats(v, mean, rstd);
        float amax = 0.f;
#pragma unroll
        for (int j = 0; j < 16; ++j) { const f32x4 sh = ldg4(md + 3 * DM, lo + 2048u * (j >> 1) + 16u * (j & 1)), scl = ldg4(md + 4 * DM, lo + 2048u * (j >> 1) + 16u * (j & 1));
            v[j] = (v[j] - mean) * rstd * (scl + 1.0f) + sh; amax = fmaxf(amax, fmaxf(fmaxf(fabsf(v[j].x), fabsf(v[j].y)), fmaxf(fabsf(v[j].z), fabsf(v[j].w)))); }
#pragma unroll
        for (int o = 1; o < 64; o <<= 1) amax = fmaxf(amax, __shfl_xor(amax, o));
        const float inv = amax > 0.f ? 127.0f / amax : 0.f;
        if (F.lane == 0) F.rsc[m] = amax * (1.0f / 127.0f);
        unsigned char* orow = (unsigned char*)F.Y + (size_t)m * DM;
#pragma unroll
        for (int j = 0; j < 8; ++j) { unsigned q[2];
#pragma unroll
            for (int h = 0; h < 2; ++h) { const f32x4 y = v[2 * j + h]; const int q0 = (int)__builtin_rintf(y.x * inv) & 0xff, q1 = (int)__builtin_rintf(y.y * inv) & 0xff, q2 = (int)__builtin_rintf(y.z * inv) & 0xff, q3 = (int)__builtin_rintf(y.w * inv) & 0xff;
                q[h] = (unsigned)(q0 | (q1 << 8) | (q2 << 16) | (q3 << 24)); }
            *(GAS v2u*)((GAS char*)orow + ln * 8u + 512u * j) = (v2u){q[0], q[1]}; }
    }
}
__device__ __forceinline__ void phase10(Frame& F) {
    const int gw = F.vcu * NWAVES + F.wave, NGW = F.G * NWAVES; const unsigned ln = (unsigned)F.lane, lo = ln * 32u;
    for (int m = gw; m < M; m += NGW) {
        f32x4 v[16]; ld_row_h((const unsigned short*)F.H + (size_t)m * DM, ln, v);
        float mean, rstd; row_stats(v, mean, rstd);
        float* orow = F.out + (size_t)m * DM;
#pragma unroll
        for (int j = 0; j < 16; ++j) { const unsigned off = lo + 2048u * (j >> 1) + 16u * (j & 1); const f32x4 g = ldg4(F.ln2g, off), b = ldg4(F.ln2b, off); stg4(orow, off, (v[j] - mean) * rstd * g + b); }
    }
}

__global__ void __launch_bounds__(NWAVES * 64, 2) enc_fwd(Args args) {
    extern __shared__ __attribute__((aligned(16))) unsigned char lds[];
    Frame F;
    F.lds = (LAS unsigned char*)lds;
    F.tid = threadIdx.x; F.lane = F.tid & 63; F.wave = __builtin_amdgcn_readfirstlane(F.tid >> 6);
    F.G = gridDim.x; { const int bx = blockIdx.x; F.vcu = (F.G % 8 == 0) ? (bx % 8) * (F.G / 8) + bx / 8 : bx; }
    gu32* ctl = (gu32*)(args.ws + WS_CTL);
    volatile LAS unsigned* MISC = (volatile LAS unsigned*)(F.lds + MISC_OFF);
    for (int u = F.tid; u < (LDS_BYTES - LDSCTL_OFF) / 4; u += NWAVES * 64) ((LAS unsigned*)(F.lds + LDSCTL_OFF))[u] = 0u;
    __syncthreads();
    XcdBarrier bar; bar.bar = (unsigned*)(ctl + CW_BAR); bar.x = 0; bar.st = nullptr;
    if (N_LAUNCHES == 1) bar = xcd_barrier_post((unsigned*)(ctl + CW_BAR), MISC + 8);
    const int lo = args.ph_lo, hi = args.ph_hi;
#ifndef PH_MASK
#define PH_MASK 0x7ff
#endif
#define IN(k) (((PH_MASK >> (k)) & 1) && lo <= (k) && (k) < hi)
#define SEAM(k) do { if (IN(k) && IN((k) + 1)) xcd_barrier(bar); } while (0)
#ifndef REP_PHASE
#define REP_PHASE -1
#endif
#define REPS(k) ((k) == REP_PHASE ? 2 : 1)
    if (IN(0)) for (int rep = 0; rep < REPS(0); ++rep) { if (rep) xcd_barrier(bar); frame_ptrs(F); phase0(F); } SEAM(0);
    if (IN(1)) for (int rep = 0; rep < REPS(1); ++rep) { if (rep) xcd_barrier(bar); frame_ptrs(F); phase1(F); } SEAM(1);
    if (IN(2)) for (int rep = 0; rep < REPS(2); ++rep) { if (rep) xcd_barrier(bar); frame_ptrs(F); if ((F.vcu & 1) == 0) { side2(F); __syncthreads(); frame_ptrs(F); } pg8::Gemm g{F.H, F.Win_t, DM, DM, DM, 0, e8m0x4(L_H1), e8m0x4(L_WIN)}; pg8::EpiProj E{F.P, F.qn, F.kn, F.rope, (LAS float*)(F.lds + LDSCTL_OFF + 1024), F.QA8, F.KA8, F.VT8, F.QB8, F.KB8, F.VTB8};
#if defined(KDOUBLE_PHASE) && KDOUBLE_PHASE == 2
        pg8::PairedOrder S; S.init(M, IN_W, F.G, (int)blockIdx.x); pg8::EpiHalf<pg8::EpiProj, false> E2{E}; pg8::gemm_phase<pg8::EpiHalf<pg8::EpiProj, false>, pg8::PairedOrder, 1>(F.lds, g, S, E2); }
#else
        pg8::StaticOrder S; S.init(M, IN_W, F.G, (int)blockIdx.x); pg8::gemm_phase<pg8::EpiProj, pg8::StaticOrder, 1>(F.lds, g, S, E); }
#endif
        if (IN(2) && (F.vcu & 1)) { frame_ptrs(F); side2(F); }
        SEAM(2);
    if (IN(4)) for (int rep = 0; rep < REPS(4); ++rep) { if (rep) xcd_barrier(bar); frame_ptrs(F); if ((F.vcu & 1) == 0) { side4(F); __syncthreads(); frame_ptrs(F); } phase4(F, (char*)lds); __syncthreads(); if (F.vcu & 1) { frame_ptrs(F); side4(F); } } SEAM(4);
    if (IN(5)) for (int rep = 0; rep < REPS(5); ++rep) { if (rep) xcd_barrier(bar); frame_ptrs(F); pg8::Gemm g{F.Y, F.Wbr_t, DM, DM, 2048, 2048, e8m0x4(L_Y), e8m0x4(L_WBR)}; pg8::PairedOrder S; S.init(M, DM, F.G, (int)blockIdx.x); pg8::EpiMerge E{F.P, (unsigned char*)F.H};
        pg8::gemm_phase<pg8::EpiMerge, pg8::PairedOrder, 1>(F.lds, g, S, E); } SEAM(5);
    if (IN(6)) for (int rep = 0; rep < REPS(6); ++rep) { if (rep) xcd_barrier(bar); frame_ptrs(F); pg8::Gemm g{F.H, F.Wo_t, DM, DM, DM, 0, e8m0x4(L_MG), e8m0x4(L_WO)}; pg8::StaticOrder S; S.init(M, DM, F.G, (int)blockIdx.x); pg8::EpiRes<false> E{F.xp, F.xs, nullptr, (unsigned short*)F.P, F.mod + 2 * DM};
        pg8::gemm_phase<pg8::EpiRes<false>, pg8::StaticOrder, 1>(F.lds, g, S, E); } SEAM(6);
    if (IN(7)) { frame_ptrs(F); phase7(F); } SEAM(7);
    if (IN(8)) for (int rep = 0; rep < REPS(8); ++rep) { if (rep) xcd_barrier(bar); frame_ptrs(F); pg8::Gemm g{F.Y, F.Wgu_t, DM, DM, DM, 0, 0, 0}; pg8::EpiSwiglu E{F.P, F.rsc, F.csc};
#if defined(KDOUBLE_PHASE) && KDOUBLE_PHASE == 8
        pg8::PairedOrder S; S.init(M, 2 * DFF, F.G, (int)blockIdx.x); pg8::EpiHalf<pg8::EpiSwiglu, true> E2{E}; pg8::gemm_phase<pg8::EpiHalf<pg8::EpiSwiglu, true>, pg8::PairedOrder, 2>(F.lds, g, S, E2); }
#else
        pg8::StaticOrder S; S.init(M, 2 * DFF, F.G, (int)blockIdx.x); pg8::gemm_phase<pg8::EpiSwiglu, pg8::StaticOrder, 2>(F.lds, g, S, E); }
#endif
        SEAM(8);
    if (IN(9)) { frame_ptrs(F); pg8::Gemm g{F.P, F.Wd_t, 2 * DFF, 2 * DFF, 2 * DFF, 0, 0, 0}; pg8::StaticOrder S; S.init(M, DM, F.G, (int)blockIdx.x, 2); pg8::EpiRes<true> E{nullptr, nullptr, (const unsigned short*)F.H, (unsigned short*)F.H, F.mod + 5 * DM};
        pg8::gemm_phase<pg8::EpiRes<true>, pg8::StaticOrder, 0>(F.lds, g, S, E); } SEAM(9);
    if (IN(10)) { frame_ptrs(F); phase10(F); }
#undef IN
#undef SEAM
}

extern "C" void kernel_launch(void* const* d_in, const int* in_sizes, int n_in, void* d_out, int out_size, void* d_ws, size_t ws_size, hipStream_t stream) {
    static int grid = 0;
    if (grid == 0) {
        if (n_in != 20 || in_sizes[0] != SEQ_P * DM || out_size != M * DM || ws_size < WS_END) {
            fprintf(stderr, "kernel_launch: shape mismatch: n_in %d in0 %d out %d ws %zu (need %zu)\n", n_in, n_in > 0 ? in_sizes[0] : -1, out_size, ws_size, (size_t)WS_END); grid = -1; return; }
        int dev = 0, cus = 0, per_cu = 0;
        if (hipGetDevice(&dev) != hipSuccess || hipDeviceGetAttribute(&cus, hipDeviceAttributeMultiprocessorCount, dev) != hipSuccess) { grid = -1; return; }
        if (hipFuncSetAttribute((const void*)enc_fwd, hipFuncAttributeMaxDynamicSharedMemorySize, LDS_BYTES) != hipSuccess) { fprintf(stderr, "kernel_launch: hipFuncSetAttribute failed\n"); grid = -1; return; }
        if (hipOccupancyMaxActiveBlocksPerMultiprocessor(&per_cu, (const void*)enc_fwd, NWAVES * 64, LDS_BYTES) != hipSuccess || per_cu < 1) { fprintf(stderr, "kernel_launch: occupancy query says %d\n", per_cu); (void)hipGetLastError(); grid = -1; return; }
        grid = cus;
    }
    if (grid < 0) return;
    (void)hipMemsetAsync((char*)d_ws + WS_CTL, 0, CTL_ZERO_BYTES, stream);
    Args a{};
    for (int i = 0; i < 20; ++i) a.in[i] = (const float*)d_in[i];
    a.out = (float*)d_out; a.ws = (unsigned char*)d_ws;
    if (N_LAUNCHES == 1) { a.ph_lo = 0; a.ph_hi = N_PHASES; hipLaunchKernelGGL(enc_fwd, dim3(grid), dim3(NWAVES * 64), LDS_BYTES, stream, a); }
    else for (int li = 0; li < N_PHASES; ++li) { a.ph_lo = li; a.ph_hi = li + 1; hipLaunchKernelGGL(enc_fwd, dim3(grid), dim3(NWAVES * 64), LDS_BYTES, stream, a); }
    const hipError_t le = hipPeekAtLastError();
    if (le != hipSuccess) fprintf(stderr, "kernel_launch: launch failed: %s\n", hipGetErrorName(le));
}
```
